# Optimizing an MI355X kernel written in HIP

```python
import math
import jax, jax.numpy as jnp
from jax import lax
import numpy as np

D_MODEL = 2048
BATCH = 4
SEQ = 4096
DEPTH = 4

N_EVEN = (DEPTH + 1) // 2
N_ODD = DEPTH // 2

CONV_WIDTH = 3
CONV_GROUPS = 8
D_CONV = D_MODEL // 2

NSA_HEADS = 8
NSA_KV_GROUPS = 2
NSA_HPG = NSA_HEADS // NSA_KV_GROUPS
HEAD_DIM = 128
D_NSA = NSA_HEADS * HEAD_DIM
D_KV = NSA_KV_GROUPS * HEAD_DIM
CMP_BLOCK = 32
CMP_STRIDE = 16
SEL_BLOCK = 64
N_SELECT = 16
WINDOW = 512
N_BRANCH = 3
Q_BLOCK = 128

EVEN_SPLITS = (D_CONV, D_CONV, D_CONV, D_CONV, D_NSA, D_KV, D_KV, D_KV, D_KV, D_KV, D_KV, N_BRANCH * NSA_HEADS, D_NSA)
EVEN_IN = sum(EVEN_SPLITS)
D_EVEN_MIX = D_CONV + D_NSA

D_SGU = D_MODEL
SGU_GROUPS = 8
SGU_CHUNK = 128
SGU_GROUP_DIM = D_SGU // SGU_GROUPS

REL_BUCKETS = 32
REL_MAX_DIST = 128

DEEPNORM_ALPHA = (2 * DEPTH) ** 0.25
DEEPNORM_BETA = (8 * DEPTH) ** -0.25
LN_EPS = 1e-5
NEG_INF = -1e30
FORCED_SCORE = 1e9

kernel_name = "hybrid_conv_nsa_sgu_deepnorm"


def layer_norm(x, g, b):
    xf = x.astype(jnp.float32)
    mu = jnp.mean(xf, axis=-1, keepdims=True)
    var = jnp.mean(jnp.square(xf - mu), axis=-1, keepdims=True)
    return ((xf - mu) * lax.rsqrt(var + LN_EPS) * g + b).astype(x.dtype)


def t5_bucket(dist):
    n = jnp.maximum(dist, 0)
    max_exact = REL_BUCKETS // 2
    large = max_exact + (jnp.log(jnp.maximum(n, 1).astype(jnp.float32) / max_exact)
                         / math.log(REL_MAX_DIST / max_exact) * (REL_BUCKETS - max_exact)).astype(jnp.int32)
    large = jnp.minimum(large, REL_BUCKETS - 1)
    return jnp.where(n < max_exact, n, large)


def causal_short_conv(h, w):
    s = h.shape[1]
    hp = jnp.pad(h, ((0, 0), (CONV_WIDTH - 1, 0), (0, 0)))
    out = w[0] * hp[:, 0:s]
    for k in range(1, CONV_WIDTH):
        out = out + w[k] * hp[:, k:k + s]
    return out


def compress_blocks(tok, pos, w1, w2):
    s = tok.shape[2]
    n_cmp = (s - CMP_BLOCK) // CMP_STRIDE + 1
    idx = np.arange(n_cmp)[:, None] * CMP_STRIDE + np.arange(CMP_BLOCK)[None, :]
    blocks = tok[:, :, idx] + pos
    flat = blocks.reshape(blocks.shape[0], blocks.shape[1], n_cmp, CMP_BLOCK * HEAD_DIM)
    return jax.nn.silu(flat @ w1) @ w2


def nsa_attention(q, k_c, v_c, k_s, v_s, k_w, v_w, gates, rel_table, cmp_pos, cmp_w1, cmp_w2):
    bsz, s, _ = q.shape
    g_n, hpg, dh = NSA_KV_GROUPS, NSA_HPG, HEAD_DIM
    scale = dh ** -0.5
    q = q.reshape(bsz, s, g_n, hpg, dh).transpose(0, 2, 3, 1, 4)

    def kv(t):
        return t.reshape(bsz, s, g_n, dh).transpose(0, 2, 1, 3)

    table_g = rel_table.reshape(REL_BUCKETS, g_n, hpg)
    table_gt = jnp.transpose(table_g, (1, 0, 2))

    kc = compress_blocks(kv(k_c), cmp_pos[0], cmp_w1[0], cmp_w2[0])
    vc = compress_blocks(kv(v_c), cmp_pos[1], cmp_w1[1], cmp_w2[1])
    n_cmp = kc.shape[2]
    t = jnp.arange(s)
    cmp_end = jnp.arange(n_cmp) * CMP_STRIDE + CMP_BLOCK - 1
    dist_c = t[:, None] - cmp_end[None, :]
    valid_c = dist_c >= 0
    bias_c = jnp.transpose(table_g[t5_bucket(dist_c)], (2, 3, 0, 1))
    s_c = jnp.einsum('bghqd,bgkd->bghqk', q, kc).astype(jnp.float32) * scale + bias_c
    p_c = jax.nn.softmax(jnp.where(valid_c, s_c, NEG_INF), axis=-1)
    p_c = jnp.where(valid_c, p_c, 0.0)
    o_c = jnp.einsum('bghqk,bgkd->bghqd', p_c.astype(vc.dtype), vc)

    n_sel = s // SEL_BLOCK
    cstart = np.arange(n_cmp)[:, None] * CMP_STRIDE
    sstart = np.arange(n_sel)[None, :] * SEL_BLOCK
    overlap = jnp.asarray(((cstart < sstart + SEL_BLOCK) & (cstart + CMP_BLOCK > sstart)).astype(np.float32))
    imp = jnp.einsum('bghqk,kj->bgqj', p_c, overlap)
    blk = jnp.arange(n_sel)[None, :]
    cur = (t // SEL_BLOCK)[:, None]
    forced = (blk == 0) | (blk == cur) | (blk == cur - 1)
    imp = jnp.where(blk > cur, -1.0, jnp.where(forced, FORCED_SCORE, imp))
    n_top = min(N_SELECT, n_sel)
    _, sel_idx = lax.top_k(imp, n_top)
    n_keys = n_top * SEL_BLOCK

    k_sel_blocks = kv(k_s).reshape(bsz, g_n, n_sel, SEL_BLOCK, dh)
    v_sel_blocks = kv(v_s).reshape(bsz, g_n, n_sel, SEL_BLOCK, dh)
    gather = jax.vmap(jax.vmap(lambda blocks, idx: blocks[idx]))
    g_idx = jnp.arange(g_n)[None, :, None, None]

    k_win_pad = jnp.pad(kv(k_w), ((0, 0), (0, 0), (WINDOW, 0), (0, 0)))
    v_win_pad = jnp.pad(kv(v_w), ((0, 0), (0, 0), (WINDOW, 0), (0, 0)))
    qi = jnp.arange(Q_BLOCK)[:, None]
    kj = jnp.arange(WINDOW + Q_BLOCK)[None, :]
    rel_w = WINDOW + qi - kj
    band = (rel_w >= 0) & (rel_w < WINDOW)
    bias_w = jnp.transpose(table_g[t5_bucket(rel_w)], (2, 3, 0, 1))

    def block_step(q0):
        qb = lax.dynamic_slice_in_dim(q, q0, Q_BLOCK, axis=3)
        tq = q0 + jnp.arange(Q_BLOCK)
        idx = lax.dynamic_slice_in_dim(sel_idx, q0, Q_BLOCK, axis=2)
        ks = gather(k_sel_blocks, idx).reshape(bsz, g_n, Q_BLOCK, n_keys, dh)
        vs = gather(v_sel_blocks, idx).reshape(bsz, g_n, Q_BLOCK, n_keys, dh)
        kpos = (idx[..., None] * SEL_BLOCK + jnp.arange(SEL_BLOCK)).reshape(bsz, g_n, Q_BLOCK, n_keys)
        dist = tq[:, None] - kpos
        bias = jnp.moveaxis(table_gt[g_idx, t5_bucket(dist)], -1, 2)
        sc = jnp.einsum('bghqd,bgqkd->bghqk', qb, ks).astype(jnp.float32) * scale + bias
        p = jax.nn.softmax(jnp.where((dist >= 0)[:, :, None], sc, NEG_INF), axis=-1)
        o_s = jnp.einsum('bghqk,bgqkd->bghqd', p.astype(vs.dtype), vs)
        kw = lax.dynamic_slice_in_dim(k_win_pad, q0, WINDOW + Q_BLOCK, axis=2)
        vw = lax.dynamic_slice_in_dim(v_win_pad, q0, WINDOW + Q_BLOCK, axis=2)
        valid = band & (kj >= WINDOW - q0)
        sw = jnp.einsum('bghqd,bgkd->bghqk', qb, kw).astype(jnp.float32) * scale + bias_w
        pw = jax.nn.softmax(jnp.where(valid, sw, NEG_INF), axis=-1)
        o_w = jnp.einsum('bghqk,bgkd->bghqd', pw.astype(vw.dtype), vw)
        return o_s, o_w

    o_s, o_w = lax.map(block_step, jnp.arange(s // Q_BLOCK) * Q_BLOCK)
    o_s = jnp.moveaxis(o_s, 0, 3).reshape(bsz, g_n, hpg, s, dh)
    o_w = jnp.moveaxis(o_w, 0, 3).reshape(bsz, g_n, hpg, s, dh)

    gate = jax.nn.sigmoid(gates.astype(jnp.float32)).reshape(bsz, s, N_BRANCH, g_n, hpg)
    gate = jnp.transpose(gate, (2, 0, 3, 4, 1))[..., None].astype(o_c.dtype)
    o = gate[0] * o_c + gate[1] * o_s + gate[2] * o_w
    return o.transpose(0, 3, 1, 2, 4).reshape(bsz, s, D_NSA)


def even_layer(x, w_in, conv_w, cmp_pos, cmp_w1, cmp_w2, w_out, rel_table):
    h = x @ w_in
    offs = [int(o) for o in np.cumsum(EVEN_SPLITS)[:-1]]
    (a_h, a_b, a_c, a_z, q, k_c, v_c, k_s, v_s, k_w, v_w, gates, b_z) = jnp.split(h, offs, axis=-1)
    y_a = a_b * causal_short_conv(a_c * a_h, conv_w) * jax.nn.silu(a_z)
    y_b = nsa_attention(q, k_c, v_c, k_s, v_s, k_w, v_w, gates, rel_table, cmp_pos, cmp_w1, cmp_w2) * jax.nn.silu(b_z)
    return jnp.concatenate([y_a, y_b], axis=-1) @ w_out


def odd_layer(x, w_in, ln_g, ln_b, sgu_w, sgu_b, w_out):
    bsz, s, _ = x.shape
    h = x @ w_in
    uv = jax.nn.gelu(h[..., :2 * D_SGU])
    z = h[..., 2 * D_SGU:]
    u, v = jnp.split(uv, 2, axis=-1)
    v = layer_norm(v, ln_g, ln_b).reshape(bsz, s // SGU_CHUNK, SGU_CHUNK, SGU_GROUPS, SGU_GROUP_DIM)
    w_causal = sgu_w * jnp.tril(jnp.ones((SGU_CHUNK, SGU_CHUNK), sgu_w.dtype))
    mixed = jnp.einsum('gts,bnsgc->bntgc', w_causal, v) + sgu_b.T[:, :, None]
    y = u * mixed.reshape(bsz, s, D_SGU) * jax.nn.silu(z)
    return y @ w_out


def setup_inputs(seed: int = 0) -> dict:
    key = jax.random.key(seed)
    ks = jax.random.split(key, 16)

    def nrm(k, shape, scale):
        return jax.random.normal(k, shape, jnp.float32) * scale

    return {
        "x": nrm(ks[0], (BATCH, SEQ, D_MODEL), 1.0),
        "rel_bias_table": nrm(ks[1], (REL_BUCKETS, NSA_HEADS), 0.5),
        "ln_g": 1.0 + nrm(ks[2], (DEPTH, D_MODEL), 0.02),
        "ln_b": nrm(ks[3], (DEPTH, D_MODEL), 0.02),
        "ev_w_in": nrm(ks[4], (N_EVEN, D_MODEL, EVEN_IN), D_MODEL ** -0.5),
        "ev_conv_w": nrm(ks[5], (N_EVEN, CONV_WIDTH, D_CONV), CONV_WIDTH ** -0.5),
        "ev_cmp_pos": nrm(ks[6], (N_EVEN, 2, CMP_BLOCK, HEAD_DIM), 0.5),
        "ev_cmp_w1": nrm(ks[7], (N_EVEN, 2, CMP_BLOCK * HEAD_DIM, HEAD_DIM), (CMP_BLOCK * HEAD_DIM) ** -0.5),
        "ev_cmp_w2": nrm(ks[8], (N_EVEN, 2, HEAD_DIM, HEAD_DIM), HEAD_DIM ** -0.5),
        "ev_w_out": nrm(ks[9], (N_EVEN, D_EVEN_MIX, D_MODEL), D_EVEN_MIX ** -0.5 * DEEPNORM_BETA),
        "od_w_in": nrm(ks[10], (N_ODD, D_MODEL, 3 * D_SGU), D_MODEL ** -0.5),
        "od_ln_g": 1.0 + nrm(ks[11], (N_ODD, D_SGU), 0.02),
        "od_ln_b": nrm(ks[12], (N_ODD, D_SGU), 0.02),
        "od_sgu_w": nrm(ks[13], (N_ODD, SGU_GROUPS, SGU_CHUNK, SGU_CHUNK), SGU_CHUNK ** -0.5),
        "od_sgu_b": 1.0 + nrm(ks[14], (N_ODD, SGU_GROUPS, SGU_CHUNK), 0.02),
        "od_w_out": nrm(ks[15], (N_ODD, D_SGU, D_MODEL), D_SGU ** -0.5 * DEEPNORM_BETA),
    }


def reference(x, rel_bias_table, ln_g, ln_b, ev_w_in, ev_conv_w, ev_cmp_pos, ev_cmp_w1, ev_cmp_w2, ev_w_out,
              od_w_in, od_ln_g, od_ln_b, od_sgu_w, od_sgu_b, od_w_out):
    for layer in range(DEPTH):
        i = layer // 2
        if layer % 2 == 0:
            y = even_layer(x, ev_w_in[i], ev_conv_w[i], ev_cmp_pos[i], ev_cmp_w1[i], ev_cmp_w2[i],
                           ev_w_out[i], rel_bias_table)
        else:
            y = odd_layer(x, od_w_in[i], od_ln_g[i], od_ln_b[i], od_sgu_w[i], od_sgu_b[i], od_w_out[i])
        x = layer_norm(DEEPNORM_ALPHA * x + y, ln_g[layer], ln_b[layer])
    return x
```

```cpp
#include <hip/hip_runtime.h>
#include <hip/hip_cooperative_groups.h>
#include <cstdio>
#include <cstdint>
namespace cg = cooperative_groups;

#define LAS __attribute__((address_space(3)))
#define GAS __attribute__((address_space(1)))
typedef unsigned short bf16_t;
typedef short bf16x8 __attribute__((ext_vector_type(8)));
typedef short s16x4 __attribute__((ext_vector_type(4)));
typedef float f32x2 __attribute__((ext_vector_type(2)));
typedef float f32x4 __attribute__((ext_vector_type(4)));
typedef float f32x16 __attribute__((ext_vector_type(16)));
typedef unsigned u32x2 __attribute__((ext_vector_type(2)));
typedef unsigned u32x4 __attribute__((ext_vector_type(4)));
typedef LAS unsigned char* ldsp;

constexpr int BATCH = 4, SEQ = 4096, DM = 2048, MTOK = BATCH * SEQ;
constexpr int EVN = 7936;
constexpr int ODN = 6144;
constexpr int EVP = 5888, ODP = 4096;
constexpr int C_P = 0, C_GZ = 1024, C_Q = 2048, C_KC = 3072, C_VC = 3328, C_KS = 3584, C_VS = 3840, C_KW = 4096, C_VW = 4352, C_BZ = 4608, C_GATE = 5632;
constexpr float LN_EPS = 1e-5f;
constexpr float DN_ALPHA = 1.681792830507429f;
constexpr float L2E = 1.4426950408889634f;
constexpr float QK_C2 = 0.08838834764831845f * 1.4426950408889634f;

constexpr size_t MiB = 1u << 20;
constexpr size_t WS_WEV = 1 * MiB;
constexpr size_t WS_WOD = 32 * MiB;
constexpr size_t WS_WOUT = 80 * MiB;
constexpr size_t WS_W1T = 112 * MiB;
constexpr size_t WS_W2T = 116 * MiB;
constexpr size_t WS_STATS = 117 * MiB;
constexpr size_t WS_RS = 117 * MiB + 512 * 1024;
constexpr size_t WS_KCVC = 118 * MiB;
constexpr size_t WS_SEL = 119 * MiB;
constexpr size_t WS_XB = 120 * MiB;
constexpr size_t WS_OB = 184 * MiB;
constexpr size_t WS_H = 248 * MiB;
constexpr size_t WS_END = 496 * MiB;

typedef __bf16 bf16x2_t __attribute__((ext_vector_type(2)));
__device__ __forceinline__ unsigned cvt_pk_bf16(float lo, float hi) { f32x2 v = {lo, hi}; bf16x2_t b = __builtin_convertvector(v, bf16x2_t); return __builtin_bit_cast(unsigned, b); }
__device__ __forceinline__ float bf2f(unsigned short h) { return __uint_as_float(((unsigned)h) << 16); }
__device__ __forceinline__ bf16x8 pack8(f32x4 a, f32x4 b) { u32x4 w = {cvt_pk_bf16(a[0], a[1]), cvt_pk_bf16(a[2], a[3]), cvt_pk_bf16(b[0], b[1]), cvt_pk_bf16(b[2], b[3])}; return __builtin_bit_cast(bf16x8, w); }
__device__ __forceinline__ void unpack8(bf16x8 v, float* f) {
#pragma unroll
    for (int i = 0; i < 8; ++i) f[i] = bf2f((unsigned short)v[i]);
}
__device__ __forceinline__ float silu_f(float x) { return x * __builtin_amdgcn_rcpf(1.f + __builtin_amdgcn_exp2f(-x * L2E)); }
__device__ __forceinline__ float sigmoid_f(float x) { return __builtin_amdgcn_rcpf(1.f + __builtin_amdgcn_exp2f(-x * L2E)); }
__device__ __forceinline__ float gelu_tanh_f(float x) { const float u = 0.7978845608028654f * (x + 0.044715f * x * x * x); return x * __builtin_amdgcn_rcpf(1.f + __builtin_amdgcn_exp2f(-2.f * L2E * u)); }
__device__ __forceinline__ float wave_sum(float v) {
#pragma unroll
    for (int o = 1; o < 64; o <<= 1) v += __shfl_xor(v, o);
    return v;
}

namespace pg8 {
constexpr int BM = 256, BK = 64, HALF = 128, HTB = HALF * BK * 2, STAGE_BYTES = 8 * HTB, NXCD = 8, WGM = 8;
__device__ __forceinline__ int lds_byte(int r, int c) { const int st = (r >> 4) * 2 + (c >> 5), rr = r & 15, cc = c & 31, ob = rr * 64 + cc * 2; return st * 1024 + (ob ^ (((ob >> 9) & 1) << 5)); }
__device__ __forceinline__ void stage_rc(int b, int& R, int& C) { const int st = b / 1024, sb = b % 1024, swz = sb ^ (((sb >> 9) & 1) << 5); R = (st >> 1) * 16 + swz / 64; C = (st & 1) * 32 + (swz % 64) / 2; }
__device__ __forceinline__ int perm32(int rho) { const int n = rho >> 4, i = rho & 15; return 8 * (i >> 2) + 4 * n + (i & 3); }
struct Unit { int pm, pn; };
struct Gemm { const bf16_t* A; const bf16_t* Bt; int M, N, K; };
struct StaticOrder {
    int nM, nN, nwg, G, c;
    __device__ void init(int M, int N, int G_, int c_) { nM = M / BM; nN = N / BM; nwg = nM * nN; G = G_; c = c_; }
    __device__ bool next(int i, Unit& u) const {
        const long L = (long)i * G + c; if (L >= nwg) return false;
        int wgid = (int)L; { const int q = nwg / NXCD, r = nwg % NXCD, xcd = wgid % NXCD, off = wgid / NXCD; wgid = (xcd < r ? xcd * (q + 1) : r * (q + 1) + (xcd - r) * q) + off; }
        const int nig = WGM * nN, gid = wgid / nig, fm = gid * WGM, gsz = (nM - fm) < WGM ? (nM - fm) : WGM;
        u.pm = fm + ((wgid % nig) % gsz); u.pn = (wgid % nig) / gsz; return true;
    }
};
template <int MODE> struct EpiBf16 {
    bf16_t* O; int ldc; int colshift; float* stats;
    __device__ __forceinline__ void operator()(const f32x4 (&acc)[2][2][4][2], const Unit& u, int wr, int wc, int fr, int fq) const {
        const int row0 = u.pm * BM + wr * 64 + fr;
        if (MODE != 0 && u.pn < 16) {
            const bool prod = (MODE == 1) && (u.pn < 8);
            const int cb = (MODE == 1 ? (u.pn & 7) * 128 + (u.pn >> 3) * 1024 : u.pn * 128) + wc * 32 + 8 * fq;
#pragma unroll
            for (int ai = 0; ai < 2; ++ai)
#pragma unroll
                for (int m = 0; m < 4; ++m) { bf16_t* rowp = O + (size_t)(row0 + ai * HALF + m * 16) * ldc + cb;
                    unsigned wv[4];
#pragma unroll
                    for (int bj = 0; bj < 2; ++bj) { const f32x4 v0 = acc[ai][bj][m][0], v1 = acc[ai][bj][m][1];
                        float r0, r1, r2, r3;
                        if (MODE == 1) {
                            if (prod) { r0 = v0[0] * v0[1]; r1 = v0[2] * v0[3]; r2 = v1[0] * v1[1]; r3 = v1[2] * v1[3]; }
                            else { r0 = v0[0] * silu_f(v0[1]); r1 = v0[2] * silu_f(v0[3]); r2 = v1[0] * silu_f(v1[1]); r3 = v1[2] * silu_f(v1[3]); } }
                        else { r0 = gelu_tanh_f(v0[0]) * silu_f(v0[1]); r1 = gelu_tanh_f(v0[2]) * silu_f(v0[3]); r2 = gelu_tanh_f(v1[0]) * silu_f(v1[1]); r3 = gelu_tanh_f(v1[2]) * silu_f(v1[3]); }
                        wv[2 * bj] = cvt_pk_bf16(r0, r1); wv[2 * bj + 1] = cvt_pk_bf16(r2, r3); }
                    *(u32x4*)rowp = (u32x4){wv[0], wv[1], wv[2], wv[3]}; }
            return;
        }
        const int col0 = u.pn * BM - colshift + wc * 32 + 8 * fq;
#pragma unroll
        for (int ai = 0; ai < 2; ++ai)
#pragma unroll
            for (int m = 0; m < 4; ++m) { bf16_t* rowp = O + (size_t)(row0 + ai * HALF + m * 16) * ldc + col0;
                float ssum = 0.f, ssq = 0.f;
#pragma unroll
                for (int bj = 0; bj < 2; ++bj) { f32x4 v0 = acc[ai][bj][m][0], v1 = acc[ai][bj][m][1];
                    if (MODE == 2) {
#pragma unroll
                        for (int e = 0; e < 4; ++e) { v0[e] = gelu_tanh_f(v0[e]); v1[e] = gelu_tanh_f(v1[e]); } }
                    u32x4 w; w.x = cvt_pk_bf16(v0[0], v0[1]); w.y = cvt_pk_bf16(v0[2], v0[3]); w.z = cvt_pk_bf16(v1[0], v1[1]); w.w = cvt_pk_bf16(v1[2], v1[3]);
                    *(u32x4*)(rowp + bj * HALF) = w;
                    if (MODE == 2) {
                        const unsigned ww[4] = {w.x, w.y, w.z, w.w};
#pragma unroll
                        for (int e = 0; e < 4; ++e) { const float a0 = __uint_as_float(ww[e] << 16), a1 = __uint_as_float(ww[e] & 0xffff0000u); ssum += a0 + a1; ssq += a0 * a0 + a1 * a1; } } }
                if (MODE == 2) {
                    ssum += __shfl_xor(ssum, 16); ssum += __shfl_xor(ssum, 32); ssq += __shfl_xor(ssq, 16); ssq += __shfl_xor(ssq, 32);
                    if (fq == 0) { float* sp = stats + (size_t)(row0 + ai * HALF + m * 16) * 2; atomicAdd(sp, ssum); atomicAdd(sp + 1, ssq); } } }
    }
};
template <bool LNRES> struct EpiResid {
    const float* res; float* out; const unsigned char* tab;
    __device__ __forceinline__ void operator()(const f32x4 (&acc)[2][2][4][2], const Unit& u, int wr, int wc, int fr, int fq) const {
        const int row0 = u.pm * BM + wr * 64 + fr; const int col0 = u.pn * BM + wc * 32 + 8 * fq;
        const float* ga = (const float*)(tab + 262144) + col0; const float* ba = (const float*)(tab + 270336) + col0;
#pragma unroll
        for (int ai = 0; ai < 2; ++ai)
#pragma unroll
            for (int m = 0; m < 4; ++m) { const int row = row0 + ai * HALF + m * 16; const size_t off = (size_t)row * DM + col0;
                float mu = 0.f, rstd = 1.f;
                if (LNRES) { const f32x2 st = *(const f32x2*)(tab + (size_t)row * 8); mu = st[0]; rstd = st[1]; }
#pragma unroll
                for (int bj = 0; bj < 2; ++bj) {
                    const f32x4 r0 = *(const f32x4*)(res + off + bj * HALF), r1 = *(const f32x4*)(res + off + bj * HALF + 4);
                    if (LNRES) {
                        const f32x4 g0 = *(const f32x4*)(ga + bj * HALF), g1 = *(const f32x4*)(ga + bj * HALF + 4), b0 = *(const f32x4*)(ba + bj * HALF), b1 = *(const f32x4*)(ba + bj * HALF + 4);
                        *(f32x4*)(out + off + bj * HALF) = ((r0 - mu) * rstd) * g0 + b0 + acc[ai][bj][m][0];
                        *(f32x4*)(out + off + bj * HALF + 4) = ((r1 - mu) * rstd) * g1 + b1 + acc[ai][bj][m][1];
                    } else {
                        *(f32x4*)(out + off + bj * HALF) = r0 * DN_ALPHA + acc[ai][bj][m][0];
                        *(f32x4*)(out + off + bj * HALF + 4) = r1 * DN_ALPHA + acc[ai][bj][m][1]; } } }
    }
};

template <class Epi>
__device__ __forceinline__ void gemm_phase(ldsp lds, const int tid, const Gemm g, const StaticOrder& S, const Epi& E) {
    const int wid = __builtin_amdgcn_readfirstlane(tid >> 6), lane = tid & 63, wr = wid >> 2, wc = wid & 3, fr = lane & 15, fq = lane >> 4;
    const int K = g.K, nt = K / BK;
    unsigned voffA[2], voffB[2];
#pragma unroll
    for (int i = 0; i < 2; ++i) { int R, C; stage_rc(tid * 16 + i * 8192, R, C); const int Rb = (R & ~31) + perm32(R & 31);
        voffA[i] = (unsigned)(R * K + C) * 2u; voffB[i] = (unsigned)(Rb * K + C) * 2u; }
    const size_t kstep = (size_t)(BK * 2);
    const size_t hstep = (size_t)HALF * K * 2;
    const size_t tstep = 2 * hstep;
    const unsigned ldsw = (unsigned)wid * 1024u;
    const int aoff = lds_byte(wr * 64 + fr, fq * 8), boff = lds_byte(wc * 32 + fr, fq * 8);
#define PG8_SA(b, h) (((b) * 2 + (h)) * HTB)
#define PG8_SB(b, h) ((4 + (b) * 2 + (h)) * HTB)
#define PG8_STAGE(bufoff, gbase, voff) do { _Pragma("unroll") for (int _i = 0; _i < 2; ++_i) \
        __builtin_amdgcn_global_load_lds((const unsigned*)((const char*)(gbase) + (voff)[_i]), (LAS unsigned*)(lds + (bufoff) + ldsw + _i * 8192), 16, 0, 0); } while (0)
#define PG8_LDA(dst, b, h) do { _Pragma("unroll") for (int m = 0; m < 4; ++m) _Pragma("unroll") for (int k = 0; k < 2; ++k) dst[m][k] = *(const LAS bf16x8*)(lds + PG8_SA(b, h) + aoff + m * 2048 + k * 1024); } while (0)
#define PG8_LDB(dst, b, h) do { _Pragma("unroll") for (int n = 0; n < 2; ++n) _Pragma("unroll") for (int k = 0; k < 2; ++k) dst[n][k] = *(const LAS bf16x8*)(lds + PG8_SB(b, h) + boff + n * 2048 + k * 1024); } while (0)
#define PG8_MMA(ai, bj, At, Bt) do { __builtin_amdgcn_s_setprio(1); _Pragma("unroll") for (int m = 0; m < 4; ++m) _Pragma("unroll") for (int n = 0; n < 2; ++n) _Pragma("unroll") for (int k = 0; k < 2; ++k) \
        acc[ai][bj][m][n] = __builtin_amdgcn_mfma_f32_16x16x32_bf16(Bt[n][k], At[m][k], acc[ai][bj][m][n], 0, 0, 0); __builtin_amdgcn_s_setprio(0); } while (0)
#define PG8_WAIT_V(n) asm volatile("s_waitcnt vmcnt(" #n ")" ::: "memory")
#define PG8_WAIT_L(n) asm volatile("s_waitcnt lgkmcnt(" #n ")" ::: "memory")
#define PG8_BAR __builtin_amdgcn_s_barrier()
#define PG8_SCHED __builtin_amdgcn_sched_barrier(0)
    Unit cur, nxt; int ui = 0;
    if (!S.next(0, cur)) return;
    f32x4 acc[2][2][4][2];
#pragma unroll
    for (int a = 0; a < 2; ++a)
#pragma unroll
        for (int b = 0; b < 2; ++b)
#pragma unroll
            for (int m = 0; m < 4; ++m)
#pragma unroll
                for (int n = 0; n < 2; ++n) acc[a][b][m][n] = (f32x4){0.f, 0.f, 0.f, 0.f};
    bf16x8 At[4][2], B0[2][2], B1[2][2];
    const char* cA = (const char*)g.A + (size_t)cur.pm * tstep; const char* cB = (const char*)g.Bt + (size_t)cur.pn * tstep;
    PG8_STAGE(PG8_SB(0, 0), cB, voffB); PG8_STAGE(PG8_SB(0, 1), cB + hstep, voffB); PG8_STAGE(PG8_SA(0, 0), cA, voffA); PG8_STAGE(PG8_SA(0, 1), cA + hstep, voffA);
    if (wr == 1) PG8_BAR;
    PG8_WAIT_V(2); PG8_BAR;
    PG8_STAGE(PG8_SB(1, 0), cB + kstep, voffB); PG8_STAGE(PG8_SA(1, 0), cA + kstep, voffA); PG8_STAGE(PG8_SB(1, 1), cB + hstep + kstep, voffB);
    PG8_WAIT_V(6); PG8_BAR;
    for (;;) {
        const bool has_next = S.next(ui + 1, nxt);
        const char* nA = has_next ? (const char*)g.A + (size_t)nxt.pm * tstep : cA; const char* nB = has_next ? (const char*)g.Bt + (size_t)nxt.pn * tstep : cB;
        for (int t = 0; t < nt; t += 2) {
            const bool last = (t == nt - 2);
            const char* a1 = cA + (size_t)(t + 1) * kstep;
            const char* a2 = last ? nA : cA + (size_t)(t + 2) * kstep; const char* b2 = last ? nB : cB + (size_t)(t + 2) * kstep;
            const char* a3 = a2 + kstep; const char* b3 = b2 + kstep;
            PG8_LDB(B0, 0, 0); PG8_LDB(B1, 0, 1); PG8_SCHED; PG8_LDA(At, 0, 0); PG8_STAGE(PG8_SA(1, 1), a1 + hstep, voffA);
            PG8_WAIT_V(8); PG8_WAIT_L(0); PG8_BAR; PG8_MMA(0, 0, At, B0); PG8_MMA(0, 1, At, B1); PG8_BAR; PG8_SCHED;
            PG8_LDA(At, 0, 1); PG8_STAGE(PG8_SB(0, 0), b2, voffB); PG8_STAGE(PG8_SB(0, 1), b2 + hstep, voffB); PG8_STAGE(PG8_SA(0, 0), a2, voffA);
            PG8_WAIT_V(8); PG8_WAIT_L(0); PG8_BAR; PG8_MMA(1, 0, At, B0); PG8_MMA(1, 1, At, B1); PG8_BAR; PG8_SCHED;
            PG8_LDB(B0, 1, 0); PG8_LDB(B1, 1, 1); PG8_SCHED; PG8_LDA(At, 1, 0); PG8_STAGE(PG8_SA(0, 1), a2 + hstep, voffA);
            PG8_WAIT_V(8); PG8_WAIT_L(0); PG8_BAR; PG8_MMA(0, 0, At, B0); PG8_MMA(0, 1, At, B1); PG8_BAR; PG8_SCHED;
            PG8_LDA(At, 1, 1); PG8_STAGE(PG8_SB(1, 0), b3, voffB); PG8_STAGE(PG8_SB(1, 1), b3 + hstep, voffB); PG8_STAGE(PG8_SA(1, 0), a3, voffA);
            PG8_WAIT_V(8); PG8_WAIT_L(0); PG8_BAR; PG8_MMA(1, 0, At, B0); PG8_MMA(1, 1, At, B1); PG8_BAR; PG8_SCHED;
        }
        if (wr == 0) PG8_BAR;
        E(acc, cur, wr, wc, fr, fq);
        if (!has_next) break;
#pragma unroll
        for (int a = 0; a < 2; ++a)
#pragma unroll
            for (int b = 0; b < 2; ++b)
#pragma unroll
                for (int m = 0; m < 4; ++m)
#pragma unroll
                    for (int n = 0; n < 2; ++n) acc[a][b][m][n] = (f32x4){0.f, 0.f, 0.f, 0.f};
        cur = nxt; cA = nA; cB = nB; ++ui;
        if (wr == 1) PG8_BAR;
    }
    PG8_WAIT_V(0);
    PG8_BAR;
#undef PG8_SA
#undef PG8_SB
#undef PG8_STAGE
#undef PG8_LDA
#undef PG8_LDB
#undef PG8_MMA
#undef PG8_WAIT_V
#undef PG8_WAIT_L
#undef PG8_BAR
#undef PG8_SCHED
}
}

#define KSWZ(row, colB) ((row) * 256 + ((colB) ^ (((row) & 7) << 4)))
#define SBAR() __builtin_amdgcn_sched_barrier(0)
constexpr int TILE_B = 16384;
__device__ __forceinline__ int v_st(int k, int c) { const int kk = (k & ~0xC) | ((k & 4) << 1) | ((k & 8) >> 1); return ((kk >> 3) * 4 + (c >> 5)) * 512 + ((kk & 7) * 32 + (c & 31)) * 2; }
__device__ __forceinline__ int v_rd_base(int lane) { return ((lane & 3) << 3) | (((lane >> 2) & 3) << 6) | (((lane >> 4) & 1) << 5) | (((lane >> 5) & 1) << 8); }
__device__ __forceinline__ int crow(int r, int hi) { return (r & 3) + 8 * (r >> 2) + 4 * hi; }

__device__ __forceinline__ void qkt_acc(f32x16& p0, f32x16& p1, ldsp Kl, int r32, int hi, const bf16x8* qr) {
    ldsp kb[4];
#pragma unroll
    for (int dd = 0; dd < 4; ++dd) kb[dd] = Kl + KSWZ(r32, (dd * 16 + hi * 8) * 2);
#pragma unroll
    for (int d0 = 0; d0 < 8; ++d0) { ldsp a = kb[d0 & 3] + (d0 >> 2) * 128;
        const bf16x8 b0 = *(const LAS bf16x8*)a;
        const bf16x8 b1 = *(const LAS bf16x8*)(a + 32 * 256);
        p0 = __builtin_amdgcn_mfma_f32_32x32x16_bf16(b0, qr[d0], p0, 0, 0, 0);
        p1 = __builtin_amdgcn_mfma_f32_32x32x16_bf16(b1, qr[d0], p1, 0, 0, 0); }
}
__device__ __forceinline__ void pv_tile(f32x16* o, int vb0, bf16x8 pa0, bf16x8 pa1, bf16x8 pa2, bf16x8 pa3) {
#define TRRD(dst, off) asm volatile("ds_read_b64_tr_b16 %0, %1 offset:%2" : "=&v"(dst) : "v"(vb0), "i"(off) : "memory")
#define PV_D0(d0) do { s16x4 l0, l1, l2, l3, h0, h1, h2, h3; constexpr int b_ = (d0) * 512; \
        TRRD(l0, b_); TRRD(h0, b_ + 2048); TRRD(l1, b_ + 4096); TRRD(h1, b_ + 6144); TRRD(l2, b_ + 8192); TRRD(h2, b_ + 10240); TRRD(l3, b_ + 12288); TRRD(h3, b_ + 14336); \
        asm volatile("s_waitcnt lgkmcnt(0)" ::: "memory"); SBAR(); \
        o[d0] = __builtin_amdgcn_mfma_f32_32x32x16_bf16(pa0, (bf16x8){l0[0], l0[1], l0[2], l0[3], h0[0], h0[1], h0[2], h0[3]}, o[d0], 0, 0, 0); \
        o[d0] = __builtin_amdgcn_mfma_f32_32x32x16_bf16(pa1, (bf16x8){l1[0], l1[1], l1[2], l1[3], h1[0], h1[1], h1[2], h1[3]}, o[d0], 0, 0, 0); \
        o[d0] = __builtin_amdgcn_mfma_f32_32x32x16_bf16(pa2, (bf16x8){l2[0], l2[1], l2[2], l2[3], h2[0], h2[1], h2[2], h2[3]}, o[d0], 0, 0, 0); \
        o[d0] = __builtin_amdgcn_mfma_f32_32x32x16_bf16(pa3, (bf16x8){l3[0], l3[1], l3[2], l3[3], h3[0], h3[1], h3[2], h3[3]}, o[d0], 0, 0, 0); } while (0)
    PV_D0(0); PV_D0(1); PV_D0(2); PV_D0(3);
#undef PV_D0
#undef TRRD
}
#define PK4(P, B_, OUT) do { unsigned a0 = cvt_pk_bf16(P[B_+0], P[B_+1]), a1 = cvt_pk_bf16(P[B_+2], P[B_+3]); \
        unsigned b0 = cvt_pk_bf16(P[B_+4], P[B_+5]), b1 = cvt_pk_bf16(P[B_+6], P[B_+7]); \
        auto r0 = __builtin_amdgcn_permlane32_swap(a0, b0, false, false); auto r1 = __builtin_amdgcn_permlane32_swap(a1, b1, false, false); \
        u32x4 w = {r0[0], r1[0], r0[1], r1[1]}; OUT = __builtin_bit_cast(bf16x8, w); } while (0)
__device__ __forceinline__ float pair_max(float v) { auto rr = __builtin_amdgcn_permlane32_swap(__float_as_uint(v), __float_as_uint(v), false, false); return fmaxf(__uint_as_float(rr[0]), __uint_as_float(rr[1])); }
__device__ __forceinline__ float pair_sum(float v) { auto rr = __builtin_amdgcn_permlane32_swap(__float_as_uint(v), __float_as_uint(v), false, false); return __uint_as_float(rr[0]) + __uint_as_float(rr[1]); }

struct Params { const float* in[16]; float* out; unsigned char* ws; };

constexpr int AL_V = 0, AL_K = TILE_B, AL_BUF = 2 * TILE_B  , AL_WS = 4 * TILE_B, AL_LUT = AL_WS + 8192, AL_IMP = AL_LUT + 2048;

template <int MODE>
__device__ __forceinline__ void score_xform(f32x16& p0, f32x16& p1, int tq, int jt, int hi, const LAS float* lut, bool fast, bool selbit) {
    const float NEG = -__builtin_inff();
    if (fast) {
        const float b31 = lut[127];
#pragma unroll
        for (int r = 0; r < 16; ++r) { p0[r] = fmaf(p0[r], QK_C2, b31); p1[r] = fmaf(p1[r], QK_C2, b31); }
        if (MODE == 1) { if (!selbit) {
#pragma unroll
            for (int r = 0; r < 16; ++r) { p0[r] = NEG; p1[r] = NEG; } } }
    } else {
#pragma unroll
        for (int r = 0; r < 16; ++r) {
            const int c = (r & 3) + 8 * (r >> 2) + 4 * hi;
#pragma unroll
            for (int half = 0; half < 2; ++half) {
                const int kk = jt * 64 + half * 32 + c;
                int dist; bool valid;
                if (MODE == 0) { dist = tq - (16 * kk + 31); valid = (dist >= 0) && (kk < 255); }
                else if (MODE == 1) { dist = tq - kk; valid = (dist >= 0) && selbit; }
                else { dist = tq - kk; valid = (unsigned)dist < 512u; }
                int idx = dist < 0 ? 0 : dist; idx = idx > 127 ? 127 : idx;
                const float raw = half ? p1[r] : p0[r];
                float bias = lut[idx]; asm volatile("" : "+v"(bias));
                const float s = valid ? fmaf(raw, QK_C2, bias) : NEG;
                if (half) p1[r] = s; else p0[r] = s;
            }
        }
    }
}

__device__ __forceinline__ void stage_k(ldsp Kl, const bf16_t* g, size_t pitch, int sr, int sc) {
    const bf16x8 a = *(const bf16x8*)(g + (size_t)sr * pitch + sc), b = *(const bf16x8*)(g + (size_t)(sr + 32) * pitch + sc);
    *(LAS bf16x8*)(Kl + KSWZ(sr, sc * 2)) = a; *(LAS bf16x8*)(Kl + KSWZ(sr, sc * 2) + 32 * 256) = b;
}
__device__ __forceinline__ void stage_v(ldsp Vl, const bf16_t* g, size_t pitch, int sr, int sc) {
    const bf16x8 a = *(const bf16x8*)(g + (size_t)sr * pitch + sc), b = *(const bf16x8*)(g + (size_t)(sr + 32) * pitch + sc);
    *(LAS bf16x8*)(Vl + v_st(sr, sc)) = a; *(LAS bf16x8*)(Vl + v_st(sr + 32, sc)) = b;
}

template <int MODE>
__device__ __forceinline__ void attn_unit(const Params& P, ldsp lds, const int tid, int b, int g, int qt) {
    const int wid = __builtin_amdgcn_readfirstlane(tid >> 6), lane = tid & 63; int r32 = lane & 31, hi = lane >> 5;
    asm volatile("" : "+v"(r32), "+v"(hi));
    const int hl = wid >> 1, th = wid & 1, hg = g * 4 + hl;
    const int tq = qt * 64 + th * 32 + r32;
    const size_t rowg = (size_t)b * SEQ + tq;
    const bf16_t* H = (const bf16_t*)(P.ws + WS_H);
    bf16_t* OB = (bf16_t*)(P.ws + WS_OB);
    unsigned long long* SEL = (unsigned long long*)(P.ws + WS_SEL);
    constexpr bool PIPE = (MODE != 0);
    constexpr int WSO = PIPE ? 6 * TILE_B : AL_WS, LUTO = WSO + 8192;
    LAS float* wsf = (LAS float*)(lds + WSO) + wid * 256;
    LAS float* lut = (LAS float*)(lds + LUTO) + hl * 128;
    const int sr = tid >> 4, sc = (tid & 15) * 8;
    __syncthreads();
    {
        const int h4 = tid >> 7, d = tid & 127;
        int bk = d;
        if (d >= 16) { bk = 16 + (int)(logf((float)d * (1.f / 16.f)) * (16.f / 2.0794415416798357f)); bk = bk > 31 ? 31 : bk; }
        ((LAS float*)(lds + LUTO))[h4 * 128 + d] = P.in[1][bk * 8 + g * 4 + h4] * L2E;
    }
    bf16x8 qr[8];
#pragma unroll
    for (int d0 = 0; d0 < 8; ++d0) qr[d0] = *(const bf16x8*)(H + rowg * EVP + C_Q + hg * 128 + d0 * 16 + hi * 8);
    unsigned long long selmask = 0ull;
    if (MODE == 1) selmask = SEL[((size_t)b * 2 + g) * SEQ + tq];
    const bf16_t* Kg; const bf16_t* Vg; size_t pitch;
    if (MODE == 0) { const bf16_t* KC = (const bf16_t*)(P.ws + WS_KCVC); Kg = KC + ((size_t)(0 * 4 + b) * 2 + g) * 256 * 128; Vg = KC + ((size_t)(1 * 4 + b) * 2 + g) * 256 * 128; pitch = 128; }
    else if (MODE == 1) { Kg = H + (size_t)b * SEQ * EVP + C_KS + g * 128; Vg = H + (size_t)b * SEQ * EVP + C_VS + g * 128; pitch = EVP; }
    else { Kg = H + (size_t)b * SEQ * EVP + C_KW + g * 128; Vg = H + (size_t)b * SEQ * EVP + C_VW + g * 128; pitch = EVP; }
    int j_lo = 0, j_hi = qt;
    if (MODE == 0) { j_lo = 0; j_hi = (4 * qt + 2) >> 6; }
    if (MODE == 2) { j_lo = qt - 8 < 0 ? 0 : qt - 8; }
    const int vbase = (int)(unsigned)(size_t)(lds + AL_V) + v_rd_base(lane);
    bf16x8 rk0, rk1, rv0, rv1;
    const size_t go0 = (size_t)sr * pitch + sc, go1 = (size_t)(sr + 32) * pitch + sc;
    const int kso = KSWZ(sr, sc * 2), vso0 = v_st(sr, sc), vso1 = v_st(sr + 32, sc);
#define LOADK(jt_) do { const bf16_t* kp_ = Kg + (size_t)(jt_) * 64 * pitch; rk0 = *(const bf16x8*)(kp_ + go0); rk1 = *(const bf16x8*)(kp_ + go1); } while (0)
#define LOADV(jt_) do { const bf16_t* vp_ = Vg + (size_t)(jt_) * 64 * pitch; rv0 = *(const bf16x8*)(vp_ + go0); rv1 = *(const bf16x8*)(vp_ + go1); } while (0)
#define WRITEK(bf_) do { ldsp kl_ = lds + AL_K + (bf_) * AL_BUF; *(LAS bf16x8*)(kl_ + kso) = rk0; *(LAS bf16x8*)(kl_ + kso + 32 * 256) = rk1; } while (0)
#define WRITEV(bf_) do { ldsp vl_ = lds + AL_V + (bf_) * AL_BUF; *(LAS bf16x8*)(vl_ + vso0) = rv0; *(LAS bf16x8*)(vl_ + vso1) = rv1; } while (0)
    const int tw0 = qt * 64 + th * 32;
    float m_reg = -1e30f, l_reg = 0.f;
    f32x16 o[4];
#pragma unroll
    for (int d = 0; d < 4; ++d) o[d] = (f32x16){0.f};
    f32x16 p0, p1;

    if (MODE == 0) {
        LOADK(j_lo); WRITEK(0); __syncthreads();
        for (int jt = j_lo; jt <= j_hi; ++jt) {
            const int cur = (jt - j_lo) & 1;
            if (jt < j_hi) { LOADK(jt + 1); }
            SBAR();
            p0 = (f32x16){0.f}; p1 = (f32x16){0.f};
            qkt_acc(p0, p1, lds + AL_K + cur * AL_BUF, r32, hi, qr);
            int tql = tq; asm volatile("" : "+v"(tql));
            score_xform<0>(p0, p1, tql, jt, hi, lut, (jt < 3) && ((tw0 - (16 * (jt * 64 + 63) + 31)) >= 128), true);
            float pmax = p0[0];
#pragma unroll
            for (int r = 1; r < 16; ++r) pmax = fmaxf(pmax, p0[r]);
#pragma unroll
            for (int r = 0; r < 16; ++r) pmax = fmaxf(pmax, p1[r]);
            pmax = pair_max(pmax);
            const float mn = fmaxf(m_reg, pmax); const float alpha = __builtin_amdgcn_exp2f(m_reg - mn); m_reg = mn;
            float ps = 0.f;
#pragma unroll
            for (int r = 0; r < 16; ++r) ps += __builtin_amdgcn_exp2f(p0[r] - mn) + __builtin_amdgcn_exp2f(p1[r] - mn);
            ps = pair_sum(ps);
            l_reg = l_reg * alpha + ps;
            if (jt < j_hi) { WRITEK(cur ^ 1); }
            __syncthreads();
        }
    }
    const float inv_l0 = (MODE == 0) ? (l_reg > 0.f ? 1.f / l_reg : 0.f) : 1.f;
    float carry = 0.f;
    bf16x8 pa0, pa1, pa2, pa3;
    unsigned gok[2], gov[2];
#pragma unroll
    for (int i = 0; i < 2; ++i) {
        const int row = i * 32 + (tid >> 4); const int colB = ((tid & 15) * 16) ^ ((row & 7) << 4);
        gok[i] = (unsigned)(row * (int)pitch + (colB >> 1));
        const int stl = i * 16 + (tid >> 5), off = (tid & 31) * 16; const int kk = (stl >> 2) * 8 + (off >> 6);
        const int kx = (kk & ~0xC) | ((kk & 4) << 1) | ((kk & 8) >> 1); const int cx = (stl & 3) * 32 + ((off & 63) >> 1);
        gov[i] = (unsigned)(kx * (int)pitch + cx);
    }
#define DMA_K(tile_, slot_) do { const bf16_t* kp_ = Kg + (size_t)(tile_) * 64 * pitch; _Pragma("unroll") for (int i_ = 0; i_ < 2; ++i_) \
        __builtin_amdgcn_global_load_lds((const unsigned*)(kp_ + gok[i_]), (LAS unsigned*)(lds + (slot_) * TILE_B + wid * 1024 + i_ * 8192), 16, 0, 0); } while (0)
#define DMA_V(tile_, slot_) do { const bf16_t* vp_ = Vg + (size_t)(tile_) * 64 * pitch; _Pragma("unroll") for (int i_ = 0; i_ < 2; ++i_) \
        __builtin_amdgcn_global_load_lds((const unsigned*)(vp_ + gov[i_]), (LAS unsigned*)(lds + (3 + (slot_)) * TILE_B + wid * 1024 + i_ * 8192), 16, 0, 0); } while (0)
    int s0 = 0, s1 = 1, s2 = 2;
    if (PIPE) {
        asm volatile("" :: "v"(qr[0]), "v"(qr[1]), "v"(qr[2]), "v"(qr[3]), "v"(qr[4]), "v"(qr[5]), "v"(qr[6]), "v"(qr[7]), "v"(selmask));
        DMA_K(j_lo, 0); DMA_K(j_lo + 1 > j_hi ? j_hi : j_lo + 1, 1); DMA_V(j_lo, 0);
        asm volatile("s_waitcnt vmcnt(0) lgkmcnt(0)" ::: "memory"); __builtin_amdgcn_s_barrier(); asm volatile("" ::: "memory");
    } else { LOADK(j_lo); LOADV(j_lo); WRITEK(0); WRITEV(0); __syncthreads(); }
    for (int jt = j_lo; jt <= j_hi; ++jt) {
        const int cur = (jt - j_lo) & 1;
        if (PIPE) { DMA_K(jt + 2 > j_hi ? j_hi : jt + 2, s2); DMA_V(jt + 1 > j_hi ? j_hi : jt + 1, s1); }
        else if (jt < j_hi) { LOADK(jt + 1); LOADV(jt + 1); }
        SBAR();
        p0 = (f32x16){0.f}; p1 = (f32x16){0.f};
        qkt_acc(p0, p1, PIPE ? lds + s0 * TILE_B : lds + AL_K + cur * AL_BUF, r32, hi, qr);
        if (PIPE) { if (jt > j_lo) pv_tile(o, vbase + (3 + s2) * TILE_B, pa0, pa1, pa2, pa3); }
        bool fast = false; bool selbit = true;
        if (MODE == 1) { selbit = (selmask >> jt) & 1ull; fast = (tw0 - (jt * 64 + 63)) >= 128; }
        if (MODE == 2) { fast = ((tw0 - (jt * 64 + 63)) >= 128) && ((tw0 + 31 - jt * 64) < 512); }
        int tql = tq; asm volatile("" : "+v"(tql));
        if (MODE == 0) score_xform<0>(p0, p1, tql, jt, hi, lut, (jt < 3) && ((tw0 - (16 * (jt * 64 + 63) + 31)) >= 128), true);
        else if (!fast) score_xform<MODE>(p0, p1, tql, jt, hi, lut, false, selbit);
        if (MODE == 0) {
#pragma unroll
            for (int r = 0; r < 16; ++r) { p0[r] = __builtin_amdgcn_exp2f(p0[r] - m_reg) * inv_l0; p1[r] = __builtin_amdgcn_exp2f(p1[r] - m_reg) * inv_l0; }
#pragma unroll
            for (int half = 0; half < 2; ++half) {
                float A[4], Bq[4], pB[4];
#pragma unroll
                for (int q = 0; q < 4; ++q) { const float x0 = half ? p1[4 * q] : p0[4 * q], x1 = half ? p1[4 * q + 1] : p0[4 * q + 1], x2 = half ? p1[4 * q + 2] : p0[4 * q + 2], x3 = half ? p1[4 * q + 3] : p0[4 * q + 3];
                    A[q] = (x0 + x1) + (x2 + x3); Bq[q] = x3; }
#pragma unroll
                for (int q = 0; q < 4; ++q) pB[q] = __shfl_xor(Bq[q], 32);
                if (hi) {
#pragma unroll
                    for (int q = 0; q < 4; ++q) A[q] += pB[q];
                } else { A[0] += carry; A[1] += pB[0]; A[2] += pB[1]; A[3] += pB[2]; carry = pB[3]; }
                LAS float* slab = (LAS float*)(lds + AL_IMP) + ((hl * 64 + th * 32 + r32) * 65) + 16 * jt + 8 * half + hi;
#pragma unroll
                for (int q = 0; q < 4; ++q) slab[2 * q] = A[q];
            }
        } else {
            float pmax = p0[0];
#pragma unroll
            for (int r = 1; r < 16; ++r) pmax = fmaxf(pmax, p0[r]);
#pragma unroll
            for (int r = 0; r < 16; ++r) pmax = fmaxf(pmax, p1[r]);
            pmax = pair_max(pmax);
            const float NEGI = -__builtin_inff();
            float boff = 0.f;
            if (fast) { boff = lut[127]; pmax = fmaf(pmax, QK_C2, boff); if (MODE == 1 && !selbit) { pmax = NEGI; boff = NEGI; } }
            float mn, alpha;
            if (__all(pmax - m_reg <= 8.f)) { mn = m_reg; alpha = 1.f; }
            else { mn = fmaxf(m_reg, pmax); alpha = __builtin_amdgcn_exp2f(m_reg - mn); m_reg = mn; }
            float ps = 0.f;
            if (fast) { const float off = boff - mn;
#pragma unroll
                for (int r = 0; r < 16; ++r) { p0[r] = __builtin_amdgcn_exp2f(fmaf(p0[r], QK_C2, off)); p1[r] = __builtin_amdgcn_exp2f(fmaf(p1[r], QK_C2, off)); ps += p0[r] + p1[r]; }
            } else {
#pragma unroll
                for (int r = 0; r < 16; ++r) { p0[r] = __builtin_amdgcn_exp2f(p0[r] - mn); p1[r] = __builtin_amdgcn_exp2f(p1[r] - mn); ps += p0[r] + p1[r]; }
            }
            ps = pair_sum(ps);
            l_reg = l_reg * alpha + ps;
            if (__any(alpha < 1.f)) {
                if (hi == 0) wsf[r32] = alpha;
#pragma unroll
                for (int r = 0; r < 16; ++r) { const float a = wsf[crow(r, hi)];
#pragma unroll
                    for (int d = 0; d < 4; ++d) o[d][r] *= a; }
            }
        }
        PK4(p0, 0, pa0); PK4(p0, 8, pa1); PK4(p1, 0, pa2); PK4(p1, 8, pa3);
        if (PIPE) {
            asm volatile("s_waitcnt vmcnt(4) lgkmcnt(0)" ::: "memory"); __builtin_amdgcn_s_barrier(); asm volatile("" ::: "memory");
            const int t_ = s0; s0 = s1; s1 = s2; s2 = t_;
        } else {
            pv_tile(o, vbase + cur * AL_BUF, pa0, pa1, pa2, pa3);
            if (jt < j_hi) { WRITEK(cur ^ 1); WRITEV(cur ^ 1); }
            __syncthreads();
        }
    }
    if (PIPE) { pv_tile(o, vbase + (3 + s2) * TILE_B, pa0, pa1, pa2, pa3); asm volatile("s_waitcnt vmcnt(0)" ::: "memory"); }
#undef DMA_K
#undef DMA_V
#undef LOADK
#undef LOADV
#undef WRITEK
#undef WRITEV

    asm volatile("" : "+v"(r32), "+v"(hi));
    int ln = lane; asm volatile("" : "+v"(ln));
    if (PIPE) __syncthreads();
    ldsp ost = lds + wid * 8192;
    if (MODE == 2) { if (hi == 0) wsf[r32] = l_reg > 0.f ? 1.f / l_reg : 0.f; }
    if (MODE == 1) {
        if (hi == 0) {
            const bf16_t* gp = H + rowg * EVP + C_GATE + hg;
            const float g0 = sigmoid_f(bf2f(gp[0])), g1 = sigmoid_f(bf2f(gp[8])), g2 = sigmoid_f(bf2f(gp[16]));
            wsf[r32] = g1 * (l_reg > 0.f ? 1.f / l_reg : 0.f); wsf[32 + r32] = g0; wsf[64 + r32] = g2;
        }
    }
#pragma unroll
    for (int r = 0; r < 16; ++r) { const int row = crow(r, hi);
#pragma unroll
        for (int d = 0; d < 4; ++d) *(LAS unsigned short*)(ost + row * 256 + (d * 32 + r32) * 2) = (unsigned short)(cvt_pk_bf16(o[d][r], 0.f) & 0xffffu); }
    {
        const size_t trow = (size_t)b * SEQ + tw0;
        bf16_t* MIX = (bf16_t*)(P.ws + WS_XB);
#pragma unroll
        for (int i = 0; i < 8; ++i) { const int row = i * 4 + (ln >> 4), c8 = (ln & 15) * 8;
            const bf16x8 ov = *(const LAS bf16x8*)(ost + row * 256 + c8 * 2);
            if (MODE == 0) { *(bf16x8*)(OB + (trow + row) * 1024 + hg * 128 + c8) = ov; }
            else if (MODE == 2) { float f[8]; unpack8(ov, f); const float a = wsf[row];
                *(bf16x8*)(OB + (size_t)MTOK * 1024 + (trow + row) * 1024 + hg * 128 + c8) = pack8((f32x4){f[0] * a, f[1] * a, f[2] * a, f[3] * a}, (f32x4){f[4] * a, f[5] * a, f[6] * a, f[7] * a}); }
            else { float f[8], oc[8], ow[8], bz[8]; unpack8(ov, f);
                unpack8(*(const bf16x8*)(OB + (trow + row) * 1024 + hg * 128 + c8), oc);
                unpack8(*(const bf16x8*)(OB + (size_t)MTOK * 1024 + (trow + row) * 1024 + hg * 128 + c8), ow);
                unpack8(*(const bf16x8*)(H + (trow + row) * EVP + C_BZ + hg * 128 + c8), bz);
                const float as = wsf[row], gc = wsf[32 + row], gw = wsf[64 + row];
                float y[8];
#pragma unroll
                for (int e = 0; e < 8; ++e) y[e] = (gc * oc[e] + as * f[e] + gw * ow[e]) * silu_f(bz[e]);
                *(bf16x8*)(MIX + (trow + row) * DM + 1024 + hg * 128 + c8) = pack8((f32x4){y[0], y[1], y[2], y[3]}, (f32x4){y[4], y[5], y[6], y[7]}); }
        }
    }
    if (MODE == 0) {
        __syncthreads();
        const LAS float* imp = (const LAS float*)(lds + AL_IMP);
        for (int i = 0; i < 8; ++i) {
            const int tok = wid * 8 + i;
            float v = (imp[(0 * 64 + tok) * 65 + lane] + imp[(1 * 64 + tok) * 65 + lane]) + (imp[(2 * 64 + tok) * 65 + lane] + imp[(3 * 64 + tok) * 65 + lane]);
            if (lane > qt) v = -1.f;
            else if (lane == 0 || lane == qt || lane == qt - 1) v = 1e9f;
            int rank = 0;
#pragma unroll 8
            for (int j = 0; j < 64; ++j) { const float vj = __uint_as_float(__builtin_amdgcn_readlane(__float_as_uint(v), j)); rank += (vj > v || (vj == v && j < lane)) ? 1 : 0; }
            const unsigned long long msk = __ballot((rank < 16) && (lane <= qt));
            if (lane == 0) SEL[((size_t)b * 2 + g) * SEQ + qt * 64 + tok] = msk;
        }
    }
}

__device__ __forceinline__ void qkt_acc32(f32x16& p0, ldsp Kl, int r32, int hi, const bf16x8* qr) {
    ldsp kb[4];
#pragma unroll
    for (int dd = 0; dd < 4; ++dd) kb[dd] = Kl + KSWZ(r32, (dd * 16 + hi * 8) * 2);
#pragma unroll
    for (int d0 = 0; d0 < 8; ++d0) { const bf16x8 b0 = *(const LAS bf16x8*)(kb[d0 & 3] + (d0 >> 2) * 128);
        p0 = __builtin_amdgcn_mfma_f32_32x32x16_bf16(b0, qr[d0], p0, 0, 0, 0); }
}
__device__ __forceinline__ void compress_unit(const Params& P, ldsp lds, const int tid, int li, int kv, int b, int g, int mt) {
    const int wid = __builtin_amdgcn_readfirstlane(tid >> 6), lane = tid & 63, r32 = lane & 31, hi = lane >> 5;
    const int cg4 = wid & 3, sl = wid >> 2;
    const int sr = tid >> 4, sc = (tid & 15) * 8;
    const bf16_t* H = (const bf16_t*)(P.ws + WS_H);
    const bf16_t* W1t = (const bf16_t*)(P.ws + WS_W1T) + (size_t)(li * 2 + kv) * 128 * 4096;
    const bf16_t* W2t = (const bf16_t*)(P.ws + WS_W2T) + (size_t)(li * 2 + kv) * 128 * 128;
    const float* pos = P.in[6] + (size_t)(li * 2 + kv) * 32 * 128;
    const int col0 = (kv ? C_VC : C_KC) + g * 128;
    f32x16 p0 = (f32x16){0.f};
    for (int it = 0; it < 16; ++it) {
        bf16x8 wq[8];
#pragma unroll
        for (int d0 = 0; d0 < 8; ++d0) wq[d0] = *(const bf16x8*)(W1t + ((size_t)((2 * it + sl) * 8 + d0) * 128 + (cg4 * 32 + r32)) * 16 + hi * 8);
        __syncthreads();
#pragma unroll
        for (int s = 0; s < 2; ++s) { const int l = 2 * it + s;
            const f32x4 q0 = *(const f32x4*)(pos + l * 128 + sc), q1 = *(const f32x4*)(pos + l * 128 + sc + 4);
            int tok = 16 * (mt * 32 + sr) + l; tok = tok > SEQ - 1 ? SEQ - 1 : tok;
            const bf16x8 tv = *(const bf16x8*)(H + ((size_t)b * SEQ + tok) * EVP + col0 + sc);
            float f[8]; unpack8(tv, f);
            const f32x4 a = {f[0] + q0[0], f[1] + q0[1], f[2] + q0[2], f[3] + q0[3]}, c = {f[4] + q1[0], f[5] + q1[1], f[6] + q1[2], f[7] + q1[3]};
            *(LAS bf16x8*)(lds + s * TILE_B + KSWZ(sr, sc * 2)) = pack8(a, c); }
        __syncthreads();
        qkt_acc32(p0, lds + sl * TILE_B, r32, hi, wq);
    }
    __syncthreads();
    LAS float* part = (LAS float*)(lds + 2 * TILE_B);
    if (sl == 1) {
#pragma unroll
        for (int r = 0; r < 16; ++r) part[crow(r, hi) * 128 + cg4 * 32 + r32] = p0[r];
    }
    __syncthreads();
    ldsp hid = lds + 4 * TILE_B;
    if (sl == 0) {
#pragma unroll
        for (int r = 0; r < 16; ++r) { const int ra = crow(r, hi), col = cg4 * 32 + r32;
            const float xa = silu_f(p0[r] + part[ra * 128 + col]);
            *(LAS unsigned short*)(hid + KSWZ(ra, col * 2)) = (unsigned short)(cvt_pk_bf16(xa, 0.f) & 0xffffu); }
    }
    __syncthreads();
    if (sl == 0) {
        bf16x8 wq[8];
#pragma unroll
        for (int d0 = 0; d0 < 8; ++d0) wq[d0] = *(const bf16x8*)(W2t + (size_t)(cg4 * 32 + r32) * 128 + d0 * 16 + hi * 8);
        f32x16 y0 = (f32x16){0.f};
        qkt_acc32(y0, hid, r32, hi, wq);
        bf16_t* KC = (bf16_t*)(P.ws + WS_KCVC) + (((size_t)(kv * 4 + b) * 2 + g) * 256 + mt * 32) * 128;
#pragma unroll
        for (int r = 0; r < 16; ++r) { const int ra = crow(r, hi), col = cg4 * 32 + r32;
            KC[(size_t)ra * 128 + col] = (bf16_t)(cvt_pk_bf16(y0[r], 0.f) & 0xffffu); }
    }
}

__device__ __forceinline__ void sgu_unit(const Params& P, ldsp lds, const int tid, int li, int b, int ch, int g) {
    const int wid = __builtin_amdgcn_readfirstlane(tid >> 6), lane = tid & 63, r32 = lane & 31, hi = lane >> 5;
    const bf16_t* UVZ = (const bf16_t*)(P.ws + WS_H);
    bf16_t* Y = (bf16_t*)(P.ws + WS_XB);
    const size_t row0 = (size_t)b * SEQ + (size_t)ch * 128;
    const float* stats = (const float*)(P.ws + WS_STATS) + row0 * 2;
    __syncthreads();
    const float* gam = P.in[11] + (size_t)li * 2048 + g * 256; const float* bet = P.in[12] + (size_t)li * 2048 + g * 256;
#pragma unroll
    for (int it = 0; it < 8; ++it) { const int idx = tid + 512 * it; const int s = idx >> 5, cv = (idx & 31) * 8;
        const bf16x8 vv = *(const bf16x8*)(UVZ + (row0 + s) * ODP + 2048 + g * 256 + cv);
        float f[8]; unpack8(vv, f);
        const float mean = stats[s * 2] * (1.f / 2048.f); const float rstd = 1.f / sqrtf(fmaxf(stats[s * 2 + 1] * (1.f / 2048.f) - mean * mean, 0.f) + LN_EPS);
        const f32x4 g0 = *(const f32x4*)(gam + cv), g1 = *(const f32x4*)(gam + cv + 4), b0 = *(const f32x4*)(bet + cv), b1 = *(const f32x4*)(bet + cv + 4);
        f32x4 a, c;
#pragma unroll
        for (int e = 0; e < 4; ++e) { a[e] = (f[e] - mean) * rstd * g0[e] + b0[e]; c[e] = (f[4 + e] - mean) * rstd * g1[e] + b1[e]; }
        *(LAS bf16x8*)(lds + ((s >> 6) * 2 + (cv >> 7)) * TILE_B + v_st(s & 63, cv & 127)) = pack8(a, c); }
    __syncthreads();
    const int rt = wid & 3, chh = wid >> 2;
    const int t = rt * 32 + r32;
    const float* Wg = P.in[13] + ((size_t)(li * 8 + g) * 128 + t) * 128;
    f32x16 o[4];
#pragma unroll
    for (int d = 0; d < 4; ++d) o[d] = (f32x16){0.f};
    for (int st = 0; st < 2; ++st) {
        if (st * 64 > rt * 32 + 31) break;
        bf16x8 pa[4];
#pragma unroll
        for (int i = 0; i < 4; ++i) { const int s0 = st * 64 + 16 * i + 8 * hi;
            f32x4 w0 = *(const f32x4*)(Wg + s0), w1 = *(const f32x4*)(Wg + s0 + 4);
#pragma unroll
            for (int e = 0; e < 4; ++e) { if (s0 + e > t) w0[e] = 0.f; if (s0 + 4 + e > t) w1[e] = 0.f; }
            pa[i] = pack8(w0, w1); }
        const int vb0 = (int)(unsigned)(size_t)(lds + (st * 2 + chh) * TILE_B) + v_rd_base(lane);
        pv_tile(o, vb0, pa[0], pa[1], pa[2], pa[3]);
    }
    const float* sb = P.in[14] + (size_t)(li * 8 + g) * 128;
    ldsp mx = lds + 4 * TILE_B;
#pragma unroll
    for (int r = 0; r < 16; ++r) { const int tt = rt * 32 + crow(r, hi); const float bias = sb[tt];
#pragma unroll
        for (int d = 0; d < 4; ++d) { const int col = chh * 128 + d * 32 + r32;
            *(LAS unsigned short*)(mx + tt * 512 + col * 2) = (unsigned short)(cvt_pk_bf16(o[d][r] + bias, 0.f) & 0xffffu); } }
    __syncthreads();
#pragma unroll
    for (int it = 0; it < 8; ++it) { const int idx = tid + 512 * it; const int tt = idx >> 5, cv = (idx & 31) * 8;
        const bf16_t* up = UVZ + (row0 + tt) * ODP + g * 256 + cv;
        float fu[8], fm[8];
        unpack8(*(const bf16x8*)up, fu); unpack8(*(const LAS bf16x8*)(mx + tt * 512 + cv * 2), fm);
        f32x4 a, c;
#pragma unroll
        for (int e = 0; e < 4; ++e) { a[e] = fu[e] * fm[e]; c[e] = fu[4 + e] * fm[4 + e]; }
        *(bf16x8*)(Y + (row0 + tt) * DM + g * 256 + cv) = pack8(a, c); }
}

struct TItem { const float* src; bf16_t* dst; int Nsrc, K, nvalid, alt; bf16_t* wtb; int n0, k0, frag; };
constexpr int I_EV = (DM / 64) * (EVN / 32), I_OD = (DM / 64) * (ODN / 32), I_WO = (DM / 64) * (DM / 32), I_W1 = (4096 / 64) * (128 / 32), I_W2 = (128 / 64) * (128 / 32);
constexpr int NIT_ALL = I_EV + 2 * I_OD + 4 * I_WO + 4 * I_W1 + 4 * I_W2;
__device__ __forceinline__ TItem t_plain(const float* W, int K, int N, bf16_t* WT, int item) {
    const int nblk = N / 32, kb = item / nblk, nb = item % nblk;
    TItem t; t.src = W + (size_t)(kb * 64) * N + nb * 32; t.dst = WT + (size_t)(nb * 32) * K + kb * 64; t.Nsrc = N; t.K = K; t.nvalid = 32; t.alt = 0; t.wtb = WT; t.n0 = nb * 32; t.k0 = kb * 64; t.frag = 0; return t;
}
__device__ __forceinline__ TItem t_ev(const float* W, bf16_t* WT, int item) {
    const int nblk = EVN / 32, kb = item / nblk, nb = item % nblk, n0 = nb * 32;
    int n0src, nvalid, alt = 0;
    if (n0 < 4096) { const int pn = n0 >> 8, bj = (n0 >> 7) & 1, wc = (n0 >> 5) & 3;
        n0src = (pn < 8 ? 0 : 1024) + (pn & 7) * 128 + wc * 32 + bj * 4; nvalid = 32; alt = 2048; }
    else if (n0 < 6656) { n0src = n0; nvalid = 32; } else if (n0 < 7680) { n0src = n0 + 24; nvalid = 32; } else if (n0 == 7680) { n0src = 6656; nvalid = 24; } else { n0src = 0; nvalid = 0; }
    TItem t; t.src = W + (size_t)(kb * 64) * 7704 + n0src; t.dst = WT + (size_t)n0 * DM + kb * 64; t.Nsrc = 7704; t.K = DM; t.nvalid = nvalid; t.alt = alt; t.wtb = WT; t.n0 = n0; t.k0 = kb * 64; t.frag = 0; return t;
}
__device__ __forceinline__ TItem t_od(const float* W, bf16_t* WT, int item) {
    const int nblk = ODN / 32, kb = item / nblk, nb = item % nblk, n0 = nb * 32;
    TItem t; t.dst = WT + (size_t)n0 * DM + kb * 64; t.Nsrc = ODN; t.K = DM; t.nvalid = 32; t.wtb = WT; t.n0 = n0; t.k0 = kb * 64; t.frag = 0;
    if (n0 < 4096) { const int pn = n0 >> 8, bj = (n0 >> 7) & 1, wc = (n0 >> 5) & 3; t.src = W + (size_t)(kb * 64) * ODN + pn * 128 + wc * 32 + bj * 4; t.alt = 4096; }   else { t.src = W + (size_t)(kb * 64) * ODN + 2048 + (n0 - 4096); t.alt = 0; }
    return t;
}
constexpr int IT_P0_END = I_EV + 4 * I_W1 + 4 * I_W2;
constexpr int IT_SLOT = I_OD + 2 * I_WO;
static_assert(IT_P0_END + 2 * IT_SLOT == NIT_ALL, "item map");
template <bool EVONLY>
__device__ __forceinline__ TItem t_decode(const Params& P, int li_ev, int it) {
    unsigned char* ws = P.ws;
    if (EVONLY || it < I_EV) return t_ev(P.in[4] + (size_t)li_ev * DM * 7704, (bf16_t*)(ws + WS_WEV), it);
    int r = it - I_EV;
    if (r < 4 * I_W1) { const int l = r / I_W1; TItem t = t_plain(P.in[7] + (size_t)l * 4096 * 128, 4096, 128, (bf16_t*)(ws + WS_W1T) + (size_t)l * 128 * 4096, r % I_W1); t.frag = 1; return t; } r -= 4 * I_W1;
    if (r < 4 * I_W2) { const int l = r / I_W2; return t_plain(P.in[8] + (size_t)l * 128 * 128, 128, 128, (bf16_t*)(ws + WS_W2T) + (size_t)l * 128 * 128, r % I_W2); } r -= 4 * I_W2;
    const int l = r / IT_SLOT; r -= l * IT_SLOT;
    if (r < I_OD) return t_od(P.in[10] + (size_t)l * DM * ODN, (bf16_t*)(ws + WS_WOD) + (size_t)l * ODN * DM, r);
    r -= I_OD;
    if (r < I_WO) return t_plain(P.in[9] + (size_t)l * DM * DM, DM, DM, (bf16_t*)(ws + WS_WOUT) + (size_t)l * DM * DM, r);
    r -= I_WO;
    return t_plain(P.in[15] + (size_t)l * DM * DM, DM, DM, (bf16_t*)(ws + WS_WOUT) + (size_t)(2 + l) * DM * DM, r);
}
template <bool EVONLY>
__device__ __forceinline__ void convert_loop(const Params& P, ldsp lds, int li_ev, int gw, int NGW, int wid, int lane, int it_lo = 0, int it_hi = -1) {
    LAS float* scr = (LAS float*)(lds + wid * 16384);
    const int NIT = it_hi >= 0 ? it_hi : (EVONLY ? I_EV : NIT_ALL);
    int it = it_lo + gw; if (it >= NIT) return;
    TItem cur = t_decode<EVONLY>(P, li_ev, it);
    float r[32];
    const int n = lane & 31, kh = lane >> 5;
#pragma unroll
    for (int i = 0; i < 32; ++i) r[i] = (n < cur.nvalid) ? cur.src[(size_t)(2 * i + kh) * cur.Nsrc + (cur.alt ? 8 * (n >> 3) + ((n >> 1) & 3) + (n & 1) * cur.alt : n)] : 0.f;
    for (;;) {
#pragma unroll
        for (int i = 0; i < 32; ++i) scr[(2 * i + kh) * 33 + n] = r[i];
        const int nit = it + NGW; const bool has = nit < NIT;
        TItem nxt = cur;
        if (has) { nxt = t_decode<EVONLY>(P, li_ev, nit);
#pragma unroll
            for (int i = 0; i < 32; ++i) r[i] = (n < nxt.nvalid) ? nxt.src[(size_t)(2 * i + kh) * nxt.Nsrc + (nxt.alt ? 8 * (n >> 3) + ((n >> 1) & 3) + (n & 1) * nxt.alt : n)] : 0.f; }
        asm volatile("s_waitcnt lgkmcnt(0)" ::: "memory");
        const int c = lane & 7;
#pragma unroll
        for (int j = 0; j < 4; ++j) { const int nn = (lane >> 3) + 8 * j; const LAS float* s = scr + (8 * c) * 33 + nn;
            u32x4 o; o.x = cvt_pk_bf16(s[0 * 33], s[1 * 33]); o.y = cvt_pk_bf16(s[2 * 33], s[3 * 33]); o.z = cvt_pk_bf16(s[4 * 33], s[5 * 33]); o.w = cvt_pk_bf16(s[6 * 33], s[7 * 33]);
            bf16_t* dp = cur.frag ? cur.wtb + ((size_t)(((cur.k0 + 8 * c) >> 4) * 128 + cur.n0 + nn) * 16 + ((cur.k0 + 8 * c) & 15)) : cur.dst + (size_t)nn * cur.K + 8 * c;
            *(u32x4*)dp = o; }
        asm volatile("s_waitcnt lgkmcnt(0)" ::: "memory");
        if (!has) break;
        cur = nxt; it = nit;
    }
}

template <bool FINAL>
__device__ __forceinline__ void ln_phase(const float* gam, const float* bet, const float* xres, const bf16_t* Y, float* XF, bf16_t* XB, int gw, int NGW, int lane) {
    for (int row = gw; row < MTOK; row += 2 * NGW) {
        const int row2 = row + NGW; const bool has2 = row2 < MTOK; const int rb = has2 ? row2 : row;
        const f32x4* xa = (const f32x4*)(xres + (size_t)row * DM) + lane; const u32x2* ya = (const u32x2*)(Y + (size_t)row * DM) + lane;
        const f32x4* xb = (const f32x4*)(xres + (size_t)rb * DM) + lane;  const u32x2* yb = (const u32x2*)(Y + (size_t)rb * DM) + lane;
        f32x4 va[8], vb[8]; u32x2 wa[8], wb[8];
#pragma unroll
        for (int j = 0; j < 8; ++j) { va[j] = xa[64 * j]; wa[j] = ya[64 * j]; vb[j] = xb[64 * j]; wb[j] = yb[64 * j]; }
        float sa = 0.f, sb = 0.f;
#pragma unroll
        for (int j = 0; j < 8; ++j) {
            const f32x4 fa = {__uint_as_float(wa[j].x << 16), __uint_as_float(wa[j].x & 0xffff0000u), __uint_as_float(wa[j].y << 16), __uint_as_float(wa[j].y & 0xffff0000u)};
            const f32x4 fb = {__uint_as_float(wb[j].x << 16), __uint_as_float(wb[j].x & 0xffff0000u), __uint_as_float(wb[j].y << 16), __uint_as_float(wb[j].y & 0xffff0000u)};
            va[j] = va[j] * DN_ALPHA + fa; vb[j] = vb[j] * DN_ALPHA + fb;
            sa += (va[j][0] + va[j][1]) + (va[j][2] + va[j][3]); sb += (vb[j][0] + vb[j][1]) + (vb[j][2] + vb[j][3]); }
#pragma unroll
        for (int o = 1; o < 64; o <<= 1) { sa += __shfl_xor(sa, o); sb += __shfl_xor(sb, o); }
        const float ma = sa * (1.f / DM), mb = sb * (1.f / DM); float qa = 0.f, qb = 0.f;
#pragma unroll
        for (int j = 0; j < 8; ++j) { va[j] = va[j] - ma; vb[j] = vb[j] - mb;
            qa += (va[j][0] * va[j][0] + va[j][1] * va[j][1]) + (va[j][2] * va[j][2] + va[j][3] * va[j][3]);
            qb += (vb[j][0] * vb[j][0] + vb[j][1] * vb[j][1]) + (vb[j][2] * vb[j][2] + vb[j][3] * vb[j][3]); }
#pragma unroll
        for (int o = 1; o < 64; o <<= 1) { qa += __shfl_xor(qa, o); qb += __shfl_xor(qb, o); }
        const float ra = 1.f / sqrtf(qa * (1.f / DM) + LN_EPS), rbs = 1.f / sqrtf(qb * (1.f / DM) + LN_EPS);
        f32x4* oa = (f32x4*)(XF + (size_t)row * DM) + lane; u32x2* ba = (u32x2*)(XB + (size_t)row * DM) + lane;
        f32x4* ob = (f32x4*)(XF + (size_t)rb * DM) + lane;  u32x2* bb = (u32x2*)(XB + (size_t)rb * DM) + lane;
#pragma unroll
        for (int j = 0; j < 8; ++j) { const f32x4 g4 = *((const f32x4*)gam + 64 * j + lane), b4 = *((const f32x4*)bet + 64 * j + lane);
            const f32x4 y1 = va[j] * ra * g4 + b4, y2 = vb[j] * rbs * g4 + b4;
            oa[64 * j] = y1; if (has2) ob[64 * j] = y2;
            if (!FINAL) { u32x2 w; w.x = cvt_pk_bf16(y1[0], y1[1]); w.y = cvt_pk_bf16(y1[2], y1[3]); ba[64 * j] = w;
                          if (has2) { u32x2 w2; w2.x = cvt_pk_bf16(y2[0], y2[1]); w2.y = cvt_pk_bf16(y2[2], y2[3]); bb[64 * j] = w2; } } }
    }
}

#define XB_TMO      128
#define XB_XCNT(j)  (256  + 64 * (j))
#define XB_XSUB(j)  (1280 + 64 * (j))
#define XB_XGEN(j)  (2304 + 64 * (j))
#define XB_TOP      3328
#define XB_TOPGEN   3392
#define XCD_BAR_WORDS 3456
#define XB_SPIN_CAP (1u << 18)
__device__ __forceinline__ unsigned xb_ld(unsigned* p)              { return __hip_atomic_load(p, __ATOMIC_RELAXED, __HIP_MEMORY_SCOPE_AGENT); }
__device__ __forceinline__ unsigned xb_add(unsigned* p, unsigned v) { return __hip_atomic_fetch_add(p, v, __ATOMIC_RELAXED, __HIP_MEMORY_SCOPE_AGENT); }
__device__ __forceinline__ unsigned xb_xcc_id() { return (unsigned)__builtin_amdgcn_s_getreg((3 << 11) | 20) & 0xFu; }
#define XB_SPIN(cond, bar) do { unsigned _sp = 0; while (cond) { __builtin_amdgcn_s_sleep(1); \
    if ((++_sp & 255u) == 0u) { if (xb_ld(&(bar)[XB_TMO])) break; if (_sp > XB_SPIN_CAP) { atomicAdd(&(bar)[XB_TMO], 1u); break; } } } } while (0)
struct XcdBarrier { unsigned* bar; unsigned x; volatile LAS unsigned* st; };
__device__ __forceinline__ XcdBarrier xcd_barrier_post(unsigned* bar, volatile LAS unsigned* st) {
    XcdBarrier b; b.bar = bar; b.x = xb_xcc_id(); b.st = st;
    if (threadIdx.x == 0) (void)xb_add(&bar[XB_XCNT(b.x)], 1u);
    return b;
}
__device__ __forceinline__ void xcd_barrier_complete(unsigned* bar, unsigned x, unsigned& nloc, unsigned& nx) {
    const unsigned G = gridDim.x * gridDim.y * gridDim.z;
    unsigned sum, cnt, mine, sp = 0u;
    for (;;) {
        sum = 0u; cnt = 0u; mine = 0u;
#pragma unroll
        for (unsigned j = 0; j < 16; ++j) { const unsigned c = xb_ld(&bar[XB_XCNT(j)]); sum += c; cnt += (c > 0u) ? 1u : 0u; mine = (j == x) ? c : mine; }
        if (sum == G) break;
        __builtin_amdgcn_s_sleep(1);
        if ((++sp & 255u) == 0u) { if (xb_ld(&bar[XB_TMO])) break; if (sp > XB_SPIN_CAP) { atomicAdd(&bar[XB_TMO], 1u); break; } }
    }
    nloc = mine > 0u ? mine : 1u; nx = cnt > 0u ? cnt : 1u;
}
__device__ __forceinline__ void xcd_barrier(const XcdBarrier& b) {
    asm volatile("s_waitcnt vmcnt(0)" ::: "memory");
    __syncthreads();
    if (threadIdx.x == 0) {
        unsigned* bar = b.bar;
        __builtin_amdgcn_s_waitcnt(0);
        unsigned nloc = b.st[0], nx = b.st[1];
        if (nloc == 0u) { xcd_barrier_complete(bar, b.x, nloc, nx); b.st[0] = nloc; b.st[1] = nx; }
        const unsigned old = xb_add(&bar[XB_XSUB(b.x)], 1u);
        const unsigned gen = old / nloc;
        if (old + 1u == (gen + 1u) * nloc) {
            __builtin_amdgcn_fence(__ATOMIC_RELEASE, "agent");
            asm volatile("s_waitcnt vmcnt(0)" ::: "memory");
            const unsigned og = xb_add(&bar[XB_TOP], 1u);
            const unsigned tg = og / nx;
            if (og + 1u == (tg + 1u) * nx) xb_add(&bar[XB_TOPGEN], 1u);
            else XB_SPIN(xb_ld(&bar[XB_TOPGEN]) == tg, bar);
            __builtin_amdgcn_fence(__ATOMIC_ACQUIRE, "agent");
            xb_add(&bar[XB_XGEN(b.x)], 1u);
            asm volatile("s_waitcnt vmcnt(0)" ::: "memory");
        } else {
            XB_SPIN(xb_ld(&bar[XB_XGEN(b.x)]) == gen, bar);
            __builtin_amdgcn_fence(__ATOMIC_ACQUIRE, "agent");
            asm volatile("s_waitcnt vmcnt(0)" ::: "memory");
        }
    }
    __syncthreads();
}
constexpr size_t WS_BAR = 16384;
constexpr size_t CTL_ZERO_BYTES = 65536;
constexpr int LDS_ST_OFF = 147456 - 64;

constexpr int LDS_BYTES = 147456;
static_assert(AL_IMP + 4 * 64 * 65 * 4 <= LDS_BYTES - 64, "attention LDS map");
#ifndef PH_MASK
#define PH_MASK 0xFFFF
#endif
#define PH_ON(n) (((PH_MASK) >> (n)) & 1)
#ifndef DUP_MASK
#define DUP_MASK 0
#endif
#if DUP_MASK
#define DUPLOOP(n) _Pragma("unroll") for (int dup_ = 0; dup_ < 1 + (((DUP_MASK) >> (n)) & 1) * (layer_dup_ok); ++dup_)
#else
#define DUPLOOP(n)
#endif
#define CAS __attribute__((address_space(4)))
#define KIN_(i) Pz.in[i] = (const float*)(*(GAS const float* const CAS*)(kp_ + 8 * (i)));
#define PHASE_BEGIN() \
    const CAS unsigned char* kp_ = (const CAS unsigned char*)__builtin_amdgcn_kernarg_segment_ptr(); asm volatile("" : "+s"(kp_)); \
    Params Pz; KIN_(0) KIN_(1) KIN_(2) KIN_(3) KIN_(4) KIN_(5) KIN_(6) KIN_(7) KIN_(8) KIN_(9) KIN_(10) KIN_(11) KIN_(12) KIN_(13) KIN_(14) KIN_(15) \
    float* XF = (float*)(*(GAS float* const CAS*)(kp_ + 128)); unsigned char* ws = (unsigned char*)(*(GAS unsigned char* const CAS*)(kp_ + 136)); \
    Pz.ws = ws; Pz.out = XF; \
    int lz_ = 0; asm volatile("" : "+s"(lz_)); \
    ldsp lds = (ldsp)lds_raw + lz_; \
    int tid = (int)threadIdx.x; asm volatile("" : "+v"(tid)); \
    int G = (int)gridDim.x, bx = (int)blockIdx.x; asm volatile("" : "+s"(G), "+s"(bx)); \
    const int wid = __builtin_amdgcn_readfirstlane(tid >> 6), lane = tid & 63; \
    const int gw = bx * 8 + wid, NGW = G * 8; \
    bf16_t* XB = (bf16_t*)(ws + WS_XB); bf16_t* H = (bf16_t*)(ws + WS_H); \
    (void)lane; (void)gw; (void)NGW; (void)XB; (void)H; (void)XF; (void)lds; (void)wid;
static_assert(sizeof(Params) == 144, "kernarg layout");

template <int layer>
__device__ __forceinline__ void layer_body(unsigned char* lds_raw, const XcdBarrier& xbar, int layer_dup_ok) {
#define GRID_SYNC() xcd_barrier(xbar)
        constexpr int li = layer >> 1; (void)layer_dup_ok;
        if ((layer & 1) == 0) {
            DUPLOOP(1) if (PH_ON(1)) { PHASE_BEGIN();
              pg8::Gemm g{XB, (const bf16_t*)(ws + WS_WEV), MTOK, EVN, DM}; pg8::StaticOrder S; S.init(MTOK, EVN, G, bx);
              pg8::EpiBf16<1> E{H, EVP, 2048, nullptr}; pg8::gemm_phase(lds, tid, g, S, E);
              { const int ntile = (MTOK / 256) * (EVN / 256); const int first_idle = ntile % G;
                const int nidle = (first_idle == 0) ? G : G - first_idle; const int me = (first_idle == 0) ? bx : bx - first_idle;
                if (me >= 0) { __syncthreads(); convert_loop<false>(Pz, lds, 0, me * 8 + wid, nidle * 8, wid, lane, IT_P0_END + li * IT_SLOT, IT_P0_END + (li + 1) * IT_SLOT); } } }
            GRID_SYNC();
            DUPLOOP(2) if (PH_ON(2)) {
                PHASE_BEGIN();
                bf16_t* MIX = XB; const float* cw = Pz.in[5] + (size_t)li * 3 * 1024;
                { f32x4* sz = (f32x4*)(ws + WS_STATS); for (int i = bx * 512 + tid; i < MTOK * 2 / 4; i += G * 512) sz[i] = (f32x4){0.f, 0.f, 0.f, 0.f}; }
                const int cskip = (G > 128) ? 128 : 0;
#pragma unroll 1
                for (int it = (bx - cskip) * 512 + tid; it < MTOK * 128 && bx >= cskip; it += (G - cskip) * 512) {
                    const int row = it >> 7, cv = (it & 127) * 8, t = row & (SEQ - 1);
                    const bf16_t* hp = H + (size_t)row * EVP;
                    float pr[3][8];
#pragma unroll
                    for (int k = 0; k < 3; ++k) {
                        const int kc = t >= k ? k : 0; float a[8];
                        unpack8(*(const bf16x8*)(hp - (size_t)kc * EVP + C_P + cv), a);
#pragma unroll
                        for (int e = 0; e < 8; ++e) pr[k][e] = t >= k ? a[e] : 0.f; }
                    float gz[8]; unpack8(*(const bf16x8*)(hp + C_GZ + cv), gz);
                    float y[8];
#pragma unroll
                    for (int e = 0; e < 8; ++e) { const float cvv = cw[cv + e] * pr[2][e] + cw[1024 + cv + e] * pr[1][e] + cw[2048 + cv + e] * pr[0][e]; y[e] = gz[e] * cvv; }
                    *(bf16x8*)(MIX + (size_t)row * DM + cv) = pack8((f32x4){y[0], y[1], y[2], y[3]}, (f32x4){y[4], y[5], y[6], y[7]});
                }
            }
            DUPLOOP(4) if (PH_ON(4)) { PHASE_BEGIN();
#pragma unroll 1
              for (int c = bx; c < 128; c += G) { const int mt = c & 7, g = (c >> 3) & 1, b = (c >> 4) & 3, kv = c >> 6; compress_unit(Pz, lds, tid, li, kv, b, g, mt); } }
            DUPLOOP(3) if (PH_ON(3)) { PHASE_BEGIN();
#pragma unroll 1
              for (int u = bx; u < 512; u += G) { const int bg = u >> 6, qt = 63 - (u & 63); attn_unit<2>(Pz, lds, tid, bg >> 1, bg & 1, qt); }
              __syncthreads(); }
            GRID_SYNC();
            DUPLOOP(5) if (PH_ON(5)) { PHASE_BEGIN();
#pragma unroll 1
              for (int pp = bx; pp < 512; pp += G) { const int pr = pp & 255, bg = pr >> 5, x = pr & 31; const int qt = (pp < 256) ? 63 - x : x;
                  attn_unit<0>(Pz, lds, tid, bg >> 1, bg & 1, qt); } }
            asm volatile("s_waitcnt vmcnt(0)" ::: "memory"); __builtin_amdgcn_fence(__ATOMIC_SEQ_CST, "agent"); __syncthreads();
            DUPLOOP(6) if (PH_ON(6)) { PHASE_BEGIN();
#pragma unroll 1
              for (int pp = bx; pp < 512; pp += G) { const int pr = pp & 255, bg = pr >> 5, x = pr & 31; const int qt = (pp < 256) ? 63 - x : x;
                  attn_unit<1>(Pz, lds, tid, bg >> 1, bg & 1, qt); } }
            GRID_SYNC();
            DUPLOOP(7) if (PH_ON(7)) { PHASE_BEGIN();
              pg8::Gemm g{XB, (const bf16_t*)(ws + WS_WOUT) + (size_t)li * DM * DM, MTOK, DM, DM}; pg8::StaticOrder S; S.init(MTOK, DM, G, bx);
              pg8::EpiBf16<0> E{H, DM, 0, nullptr}; pg8::gemm_phase(lds, tid, g, S, E); }
            GRID_SYNC();
        } else {
            DUPLOOP(8) if (PH_ON(8)) { PHASE_BEGIN();
              pg8::Gemm g{XB, (const bf16_t*)(ws + WS_WOD) + (size_t)li * ODN * DM, MTOK, ODN, DM}; pg8::StaticOrder S; S.init(MTOK, ODN, G, bx);
              pg8::EpiBf16<2> E{H, ODP, 2048, (float*)(ws + WS_STATS)}; pg8::gemm_phase(lds, tid, g, S, E); }
            GRID_SYNC();
            DUPLOOP(9) if (PH_ON(9)) { PHASE_BEGIN();
#pragma unroll 1
              for (int u = bx; u < 1024; u += G) { const int g = u & 7, ch = (u >> 3) & 31, b = u >> 8; sgu_unit(Pz, lds, tid, li, b, ch, g); } }
            GRID_SYNC();
            DUPLOOP(10) if (PH_ON(10)) { PHASE_BEGIN();
              pg8::Gemm g{XB, (const bf16_t*)(ws + WS_WOUT) + (size_t)(2 + li) * DM * DM, MTOK, DM, DM}; pg8::StaticOrder S; S.init(MTOK, DM, G, bx);
              pg8::EpiBf16<0> E{H, DM, 0, nullptr}; pg8::gemm_phase(lds, tid, g, S, E); }
            GRID_SYNC();
        }
        DUPLOOP(11) if (PH_ON(11)) { PHASE_BEGIN();
          const float* xres = (layer == 0) ? Pz.in[0] : XF;
          if (layer == 3) ln_phase<true>(Pz.in[2] + (size_t)layer * DM, Pz.in[3] + (size_t)layer * DM, xres, H, XF, XB, gw, NGW, lane);
          else ln_phase<false>(Pz.in[2] + (size_t)layer * DM, Pz.in[3] + (size_t)layer * DM, xres, H, XF, XB, gw, NGW, lane);
          if (layer == 0) { __syncthreads(); convert_loop<true>(Pz, lds, 1, gw, NGW, wid, lane); } }
        if (layer < 3) GRID_SYNC();
#undef GRID_SYNC
}

__global__ void __launch_bounds__(512, 2) hybrid_fwd(Params P) {
    extern __shared__ __attribute__((aligned(16))) unsigned char lds_raw[];
    cg::grid_group grid = cg::this_grid();
    if (threadIdx.x < 4) ((volatile LAS unsigned*)((ldsp)lds_raw + LDS_ST_OFF))[threadIdx.x] = 0u;
    __syncthreads();
    const XcdBarrier xbar = xcd_barrier_post((unsigned*)(P.ws + WS_BAR), (volatile LAS unsigned*)((ldsp)lds_raw + LDS_ST_OFF));
#define GRID_SYNC() xcd_barrier(xbar)

    int layer_dup_ok = 1; (void)layer_dup_ok;
    DUPLOOP(0) if (PH_ON(0)) {
        PHASE_BEGIN();
        convert_loop<false>(Pz, lds, 0, gw, NGW, wid, lane, 0, IT_P0_END);
        const float* x = Pz.in[0];
#pragma unroll 4
        for (size_t i = (size_t)bx * 512 + tid; i < (size_t)MTOK * DM / 8; i += (size_t)G * 512) {
            const f32x4 a = *(const f32x4*)(x + i * 8), c = *(const f32x4*)(x + i * 8 + 4);
            *(bf16x8*)(XB + i * 8) = pack8(a, c); }
    }
    if (P.ws == nullptr) grid.sync();
    GRID_SYNC();

#if (DUP_MASK >> 12) & 1
#pragma unroll 1
    for (int q_ = 0; q_ < 20; ++q_) GRID_SYNC();
#endif
    layer_body<0>(lds_raw, xbar, 1); layer_body<1>(lds_raw, xbar, 1); layer_body<2>(lds_raw, xbar, 0); layer_body<3>(lds_raw, xbar, 0);
}

extern "C" void kernel_launch(void* const* d_in, const int* in_sizes, int n_in, void* d_out, int out_size, void* d_ws, size_t ws_size, hipStream_t stream) {
    static int grid = 0;
    if (grid == 0) {
        if (n_in != 16 || out_size != MTOK * DM || ws_size < WS_END) { fprintf(stderr, "kernel_launch: unexpected shapes (n_in %d out %d ws %zu)\n", n_in, out_size, ws_size); grid = -1; return; }
        int dev = 0, cus = 0, per_cu = 0;
        (void)hipGetDevice(&dev);
        (void)hipDeviceGetAttribute(&cus, hipDeviceAttributeMultiprocessorCount, dev);
        (void)hipFuncSetAttribute((const void*)hybrid_fwd, hipFuncAttributeMaxDynamicSharedMemorySize, LDS_BYTES);
        (void)hipOccupancyMaxActiveBlocksPerMultiprocessor(&per_cu, (const void*)hybrid_fwd, 512, LDS_BYTES);
        if (per_cu < 1) { fprintf(stderr, "kernel_launch: occupancy query says %d blocks/CU\n", per_cu); per_cu = 1; }
        (void)hipGetLastError();
        grid = cus > 0 ? cus : 256;
    }
    if (grid < 0) return;
    if (hipMemsetAsync(d_ws, 0, CTL_ZERO_BYTES, stream) != hipSuccess) { fprintf(stderr, "kernel_launch: memset of control words failed\n"); return; }
    Params p{};
    for (int i = 0; i < 16; ++i) p.in[i] = (const float*)d_in[i];
    p.out = (float*)d_out; p.ws = (unsigned char*)d_ws;
    void* args[] = {&p};
    hipError_t e = hipLaunchCooperativeKernel((const void*)hybrid_fwd, dim3(grid), dim3(512), args, LDS_BYTES, stream);
    if (e != hipSuccess) fprintf(stderr, "cooperative launch failed: %s (grid %d)\n", hipGetErrorString(e), grid);
}
```

```cpp
#include <hip/hip_runtime.h>
#include <hip/hip_cooperative_groups.h>
#include <cstdio>
#include <cstdint>
namespace cg = cooperative_groups;

#define LAS __attribute__((address_space(3)))
#define GAS __attribute__((address_space(1)))
typedef unsigned short bf16_t;
typedef short bf16x8 __attribute__((ext_vector_type(8)));
typedef short s16x4 __attribute__((ext_vector_type(4)));
typedef float f32x2 __attribute__((ext_vector_type(2)));
typedef float f32x4 __attribute__((ext_vector_type(4)));
typedef float f32x16 __attribute__((ext_vector_type(16)));
typedef unsigned u32x2 __attribute__((ext_vector_type(2)));
typedef unsigned u32x4 __attribute__((ext_vector_type(4)));
typedef LAS unsigned char* ldsp;

constexpr int BATCH = 4, SEQ = 4096, DM = 2048, MTOK = BATCH * SEQ;
constexpr int EVN = 7936;
constexpr int ODN = 6144;
constexpr int EVP = 5888, ODP = 4096;
constexpr int C_P = 0, C_GZ = 1024, C_Q = 2048, C_KC = 3072, C_VC = 3328, C_KS = 3584, C_VS = 3840, C_KW = 4096, C_VW = 4352, C_BZ = 4608, C_GATE = 5632;
constexpr float LN_EPS = 1e-5f;
constexpr float DN_ALPHA = 1.681792830507429f;
constexpr float L2E = 1.4426950408889634f;
constexpr float QK_C2 = 0.08838834764831845f * 1.4426950408889634f;

constexpr size_t MiB = 1u << 20;
constexpr size_t WS_WEV = 1 * MiB;
constexpr size_t WS_WOD = 32 * MiB;
constexpr size_t WS_WOUT = 80 * MiB;
constexpr size_t WS_W1T = 112 * MiB;
constexpr size_t WS_W2T = 116 * MiB;
constexpr size_t WS_STATS = 117 * MiB;
constexpr size_t WS_SGW = 117 * MiB + 512 * 1024;
constexpr size_t WS_RS = 117 * MiB + 512 * 1024;
constexpr size_t WS_KCVC = 118 * MiB;
constexpr size_t WS_SEL = 119 * MiB;
constexpr size_t WS_XB = 120 * MiB;
constexpr size_t WS_OB = 184 * MiB;
constexpr size_t WS_H = 248 * MiB;
constexpr size_t WS_END = 496 * MiB;

typedef __bf16 bf16x2_t __attribute__((ext_vector_type(2)));
__device__ __forceinline__ unsigned cvt_pk_bf16(float lo, float hi) { f32x2 v = {lo, hi}; bf16x2_t b = __builtin_convertvector(v, bf16x2_t); return __builtin_bit_cast(unsigned, b); }
__device__ __forceinline__ float bf2f(unsigned short h) { return __uint_as_float(((unsigned)h) << 16); }
__device__ __forceinline__ bf16x8 pack8(f32x4 a, f32x4 b) { u32x4 w = {cvt_pk_bf16(a[0], a[1]), cvt_pk_bf16(a[2], a[3]), cvt_pk_bf16(b[0], b[1]), cvt_pk_bf16(b[2], b[3])}; return __builtin_bit_cast(bf16x8, w); }
__device__ __forceinline__ void unpack8(bf16x8 v, float* f) {
#pragma unroll
    for (int i = 0; i < 8; ++i) f[i] = bf2f((unsigned short)v[i]);
}
__device__ __forceinline__ float silu_f(float x) { return x * __builtin_amdgcn_rcpf(1.f + __builtin_amdgcn_exp2f(-x * L2E)); }
__device__ __forceinline__ float sigmoid_f(float x) { return __builtin_amdgcn_rcpf(1.f + __builtin_amdgcn_exp2f(-x * L2E)); }
__device__ __forceinline__ float gelu_tanh_f(float x) { const float u = 0.7978845608028654f * (x + 0.044715f * x * x * x); return x * __builtin_amdgcn_rcpf(1.f + __builtin_amdgcn_exp2f(-2.f * L2E * u)); }
__device__ __forceinline__ float wave_sum(float v) {
#pragma unroll
    for (int o = 1; o < 64; o <<= 1) v += __shfl_xor(v, o);
    return v;
}

namespace pg8 {
constexpr int BM = 256, BK = 64, HALF = 128, HTB = HALF * BK * 2, STAGE_BYTES = 8 * HTB, NXCD = 8, WGM = 8;
__device__ __forceinline__ int lds_byte(int r, int c) { const int st = (r >> 4) * 2 + (c >> 5), rr = r & 15, cc = c & 31, ob = rr * 64 + cc * 2; return st * 1024 + (ob ^ (((ob >> 9) & 1) << 5)); }
__device__ __forceinline__ void stage_rc(int b, int& R, int& C) { const int st = b / 1024, sb = b % 1024, swz = sb ^ (((sb >> 9) & 1) << 5); R = (st >> 1) * 16 + swz / 64; C = (st & 1) * 32 + (swz % 64) / 2; }
__device__ __forceinline__ int perm32(int rho) { const int n = rho >> 4, i = rho & 15; return 8 * (i >> 2) + 4 * n + (i & 3); }
struct Unit { int pm, pn; };
struct Gemm { const bf16_t* A; const bf16_t* Bt; int M, N, K; };
struct StaticOrder {
    int nM, nN, nwg, G, c;
    __device__ void init(int M, int N, int G_, int c_) { nM = M / BM; nN = N / BM; nwg = nM * nN; G = G_; c = c_; }
    __device__ bool next(int i, Unit& u) const {
        const long L = (long)i * G + c; if (L >= nwg) return false;
        int wgid = (int)L; { const int q = nwg / NXCD, r = nwg % NXCD, xcd = wgid % NXCD, off = wgid / NXCD; wgid = (xcd < r ? xcd * (q + 1) : r * (q + 1) + (xcd - r) * q) + off; }
        const int nig = WGM * nN, gid = wgid / nig, fm = gid * WGM, gsz = (nM - fm) < WGM ? (nM - fm) : WGM;
        u.pm = fm + ((wgid % nig) % gsz); u.pn = (wgid % nig) / gsz; return true;
    }
};
template <int MODE> struct EpiBf16 {
    bf16_t* O; int ldc; int colshift; float* stats;
    __device__ __forceinline__ void operator()(const f32x4 (&acc)[2][2][4][2], const Unit& u, int wr, int wc, int fr, int fq) const {
        const int row0 = u.pm * BM + wr * 64 + fr;
        if (MODE != 0 && u.pn < 16) {
            const bool prod = (MODE == 1) && (u.pn < 8);
            const int cb = (MODE == 1 ? (u.pn & 7) * 128 + (u.pn >> 3) * 1024 : u.pn * 128) + wc * 32 + 8 * fq;
#pragma unroll
            for (int ai = 0; ai < 2; ++ai)
#pragma unroll
                for (int m = 0; m < 4; ++m) { bf16_t* rowp = O + (size_t)(row0 + ai * HALF + m * 16) * ldc + cb;
                    unsigned wv[4];
#pragma unroll
                    for (int bj = 0; bj < 2; ++bj) { const f32x4 v0 = acc[ai][bj][m][0], v1 = acc[ai][bj][m][1];
                        float r0, r1, r2, r3;
                        if (MODE == 1) {
                            if (prod) { r0 = v0[0] * v0[1]; r1 = v0[2] * v0[3]; r2 = v1[0] * v1[1]; r3 = v1[2] * v1[3]; }
                            else { r0 = v0[0] * silu_f(v0[1]); r1 = v0[2] * silu_f(v0[3]); r2 = v1[0] * silu_f(v1[1]); r3 = v1[2] * silu_f(v1[3]); } }
                        else { r0 = gelu_tanh_f(v0[0]) * silu_f(v0[1]); r1 = gelu_tanh_f(v0[2]) * silu_f(v0[3]); r2 = gelu_tanh_f(v1[0]) * silu_f(v1[1]); r3 = gelu_tanh_f(v1[2]) * silu_f(v1[3]); }
                        wv[2 * bj] = cvt_pk_bf16(r0, r1); wv[2 * bj + 1] = cvt_pk_bf16(r2, r3); }
                    *(u32x4*)rowp = (u32x4){wv[0], wv[1], wv[2], wv[3]}; }
            return;
        }
        const int col0 = u.pn * BM - colshift + wc * 32 + 8 * fq;
#pragma unroll
        for (int ai = 0; ai < 2; ++ai)
#pragma unroll
            for (int m = 0; m < 4; ++m) { bf16_t* rowp = O + (size_t)(row0 + ai * HALF + m * 16) * ldc + col0;
                float ssum = 0.f, ssq = 0.f;
#pragma unroll
                for (int bj = 0; bj < 2; ++bj) { f32x4 v0 = acc[ai][bj][m][0], v1 = acc[ai][bj][m][1];
                    if (MODE == 2) {
#pragma unroll
                        for (int e = 0; e < 4; ++e) { v0[e] = gelu_tanh_f(v0[e]); v1[e] = gelu_tanh_f(v1[e]); } }
                    u32x4 w; w.x = cvt_pk_bf16(v0[0], v0[1]); w.y = cvt_pk_bf16(v0[2], v0[3]); w.z = cvt_pk_bf16(v1[0], v1[1]); w.w = cvt_pk_bf16(v1[2], v1[3]);
                    *(u32x4*)(rowp + bj * HALF) = w;
                    if (MODE == 2) {
                        const unsigned ww[4] = {w.x, w.y, w.z, w.w};
#pragma unroll
                        for (int e = 0; e < 4; ++e) { const float a0 = __uint_as_float(ww[e] << 16), a1 = __uint_as_float(ww[e] & 0xffff0000u); ssum += a0 + a1; ssq += a0 * a0 + a1 * a1; } } }
                if (MODE == 2) {
                    ssum += __shfl_xor(ssum, 16); ssum += __shfl_xor(ssum, 32); ssq += __shfl_xor(ssq, 16); ssq += __shfl_xor(ssq, 32);
                    if (fq == 0) { float* sp = stats + (size_t)(row0 + ai * HALF + m * 16) * 2; atomicAdd(sp, ssum); atomicAdd(sp + 1, ssq); } } }
    }
};
template <bool LNRES> struct EpiResid {
    const float* res; float* out; const unsigned char* tab;
    __device__ __forceinline__ void operator()(const f32x4 (&acc)[2][2][4][2], const Unit& u, int wr, int wc, int fr, int fq) const {
        const int row0 = u.pm * BM + wr * 64 + fr; const int col0 = u.pn * BM + wc * 32 + 8 * fq;
        const float* ga = (const float*)(tab + 262144) + col0; const float* ba = (const float*)(tab + 270336) + col0;
#pragma unroll
        for (int ai = 0; ai < 2; ++ai)
#pragma unroll
            for (int m = 0; m < 4; ++m) { const int row = row0 + ai * HALF + m * 16; const size_t off = (size_t)row * DM + col0;
                float mu = 0.f, rstd = 1.f;
                if (LNRES) { const f32x2 st = *(const f32x2*)(tab + (size_t)row * 8); mu = st[0]; rstd = st[1]; }
#pragma unroll
                for (int bj = 0; bj < 2; ++bj) {
                    const f32x4 r0 = *(const f32x4*)(res + off + bj * HALF), r1 = *(const f32x4*)(res + off + bj * HALF + 4);
                    if (LNRES) {
                        const f32x4 g0 = *(const f32x4*)(ga + bj * HALF), g1 = *(const f32x4*)(ga + bj * HALF + 4), b0 = *(const f32x4*)(ba + bj * HALF), b1 = *(const f32x4*)(ba + bj * HALF + 4);
                        *(f32x4*)(out + off + bj * HALF) = ((r0 - mu) * rstd) * g0 + b0 + acc[ai][bj][m][0];
                        *(f32x4*)(out + off + bj * HALF + 4) = ((r1 - mu) * rstd) * g1 + b1 + acc[ai][bj][m][1];
                    } else {
                        *(f32x4*)(out + off + bj * HALF) = r0 * DN_ALPHA + acc[ai][bj][m][0];
                        *(f32x4*)(out + off + bj * HALF + 4) = r1 * DN_ALPHA + acc[ai][bj][m][1]; } } }
    }
};

template <class Epi>
__device__ __forceinline__ void gemm_phase(ldsp lds, const int tid, const Gemm g, const StaticOrder& S, const Epi& E) {
    const int wid = __builtin_amdgcn_readfirstlane(tid >> 6), lane = tid & 63, wr = wid >> 2, wc = wid & 3, fr = lane & 15, fq = lane >> 4;
    const int K = g.K, nt = K / BK;
    unsigned voffA[2], voffB[2];
#pragma unroll
    for (int i = 0; i < 2; ++i) { int R, C; stage_rc(tid * 16 + i * 8192, R, C); const int Rb = (R & ~31) + perm32(R & 31);
        voffA[i] = (unsigned)(R * K + C) * 2u; voffB[i] = (unsigned)(Rb * K + C) * 2u; }
    const size_t kstep = (size_t)(BK * 2);
    const size_t hstep = (size_t)HALF * K * 2;
    const size_t tstep = 2 * hstep;
    const unsigned ldsw = (unsigned)wid * 1024u;
    const int aoff = lds_byte(wr * 64 + fr, fq * 8), boff = lds_byte(wc * 32 + fr, fq * 8);
#define PG8_SA(b, h) (((b) * 2 + (h)) * HTB)
#define PG8_SB(b, h) ((4 + (b) * 2 + (h)) * HTB)
#define PG8_STAGE(bufoff, gbase, voff) do { _Pragma("unroll") for (int _i = 0; _i < 2; ++_i) \
        __builtin_amdgcn_global_load_lds((const unsigned*)((const char*)(gbase) + (voff)[_i]), (LAS unsigned*)(lds + (bufoff) + ldsw + _i * 8192), 16, 0, 0); } while (0)
#define PG8_LDA(dst, b, h) do { _Pragma("unroll") for (int m = 0; m < 4; ++m) _Pragma("unroll") for (int k = 0; k < 2; ++k) dst[m][k] = *(const LAS bf16x8*)(lds + PG8_SA(b, h) + aoff + m * 2048 + k * 1024); } while (0)
#define PG8_LDB(dst, b, h) do { _Pragma("unroll") for (int n = 0; n < 2; ++n) _Pragma("unroll") for (int k = 0; k < 2; ++k) dst[n][k] = *(const LAS bf16x8*)(lds + PG8_SB(b, h) + boff + n * 2048 + k * 1024); } while (0)
#define PG8_MMA(ai, bj, At, Bt) do { __builtin_amdgcn_s_setprio(1); _Pragma("unroll") for (int m = 0; m < 4; ++m) _Pragma("unroll") for (int n = 0; n < 2; ++n) _Pragma("unroll") for (int k = 0; k < 2; ++k) \
        acc[ai][bj][m][n] = __builtin_amdgcn_mfma_f32_16x16x32_bf16(Bt[n][k], At[m][k], acc[ai][bj][m][n], 0, 0, 0); __builtin_amdgcn_s_setprio(0); } while (0)
#define PG8_WAIT_V(n) asm volatile("s_waitcnt vmcnt(" #n ")" ::: "memory")
#define PG8_WAIT_L(n) asm volatile("s_waitcnt lgkmcnt(" #n ")" ::: "memory")
#define PG8_BAR __builtin_amdgcn_s_barrier()
#define PG8_SCHED __builtin_amdgcn_sched_barrier(0)
    Unit cur, nxt; int ui = 0;
    if (!S.next(0, cur)) return;
    f32x4 acc[2][2][4][2];
#pragma unroll
    for (int a = 0; a < 2; ++a)
#pragma unroll
        for (int b = 0; b < 2; ++b)
#pragma unroll
            for (int m = 0; m < 4; ++m)
#pragma unroll
                for (int n = 0; n < 2; ++n) acc[a][b][m][n] = (f32x4){0.f, 0.f, 0.f, 0.f};
    bf16x8 At[4][2], B0[2][2], B1[2][2];
    const char* cA = (const char*)g.A + (size_t)cur.pm * tstep; const char* cB = (const char*)g.Bt + (size_t)cur.pn * tstep;
    PG8_STAGE(PG8_SB(0, 0), cB, voffB); PG8_STAGE(PG8_SB(0, 1), cB + hstep, voffB); PG8_STAGE(PG8_SA(0, 0), cA, voffA); PG8_STAGE(PG8_SA(0, 1), cA + hstep, voffA);
    if (wr == 1) PG8_BAR;
    PG8_WAIT_V(2); PG8_BAR;
    PG8_STAGE(PG8_SB(1, 0), cB + kstep, voffB); PG8_STAGE(PG8_SA(1, 0), cA + kstep, voffA); PG8_STAGE(PG8_SB(1, 1), cB + hstep + kstep, voffB);
    PG8_WAIT_V(6); PG8_BAR;
    for (;;) {
        const bool has_next = S.next(ui + 1, nxt);
        const char* nA = has_next ? (const char*)g.A + (size_t)nxt.pm * tstep : cA; const char* nB = has_next ? (const char*)g.Bt + (size_t)nxt.pn * tstep : cB;
        for (int t = 0; t < nt; t += 2) {
            const bool last = (t == nt - 2);
            const char* a1 = cA + (size_t)(t + 1) * kstep;
            const char* a2 = last ? nA : cA + (size_t)(t + 2) * kstep; const char* b2 = last ? nB : cB + (size_t)(t + 2) * kstep;
            const char* a3 = a2 + kstep; const char* b3 = b2 + kstep;
            PG8_LDB(B0, 0, 0); PG8_LDB(B1, 0, 1); PG8_SCHED; PG8_LDA(At, 0, 0); PG8_STAGE(PG8_SA(1, 1), a1 + hstep, voffA);
            PG8_WAIT_V(8); PG8_WAIT_L(0); PG8_BAR; PG8_MMA(0, 0, At, B0); PG8_MMA(0, 1, At, B1); PG8_BAR; PG8_SCHED;
            PG8_LDA(At, 0, 1); PG8_STAGE(PG8_SB(0, 0), b2, voffB); PG8_STAGE(PG8_SB(0, 1), b2 + hstep, voffB); PG8_STAGE(PG8_SA(0, 0), a2, voffA);
            PG8_WAIT_V(8); PG8_WAIT_L(0); PG8_BAR; PG8_MMA(1, 0, At, B0); PG8_MMA(1, 1, At, B1); PG8_BAR; PG8_SCHED;
            PG8_LDB(B0, 1, 0); PG8_LDB(B1, 1, 1); PG8_SCHED; PG8_LDA(At, 1, 0); PG8_STAGE(PG8_SA(0, 1), a2 + hstep, voffA);
            PG8_WAIT_V(8); PG8_WAIT_L(0); PG8_BAR; PG8_MMA(0, 0, At, B0); PG8_MMA(0, 1, At, B1); PG8_BAR; PG8_SCHED;
            PG8_LDA(At, 1, 1); PG8_STAGE(PG8_SB(1, 0), b3, voffB); PG8_STAGE(PG8_SB(1, 1), b3 + hstep, voffB); PG8_STAGE(PG8_SA(1, 0), a3, voffA);
            PG8_WAIT_V(8); PG8_WAIT_L(0); PG8_BAR; PG8_MMA(1, 0, At, B0); PG8_MMA(1, 1, At, B1); PG8_BAR; PG8_SCHED;
        }
        if (wr == 0) PG8_BAR;
        E(acc, cur, wr, wc, fr, fq);
        if (!has_next) break;
#pragma unroll
        for (int a = 0; a < 2; ++a)
#pragma unroll
            for (int b = 0; b < 2; ++b)
#pragma unroll
                for (int m = 0; m < 4; ++m)
#pragma unroll
                    for (int n = 0; n < 2; ++n) acc[a][b][m][n] = (f32x4){0.f, 0.f, 0.f, 0.f};
        cur = nxt; cA = nA; cB = nB; ++ui;
        if (wr == 1) PG8_BAR;
    }
    PG8_WAIT_V(0);
    PG8_BAR;
#undef PG8_SA
#undef PG8_SB
#undef PG8_STAGE
#undef PG8_LDA
#undef PG8_LDB
#undef PG8_MMA
#undef PG8_WAIT_V
#undef PG8_WAIT_L
#undef PG8_BAR
#undef PG8_SCHED
}
}

#define KSWZ(row, colB) ((row) * 256 + ((colB) ^ (((row) & 7) << 4)))
#define SBAR() __builtin_amdgcn_sched_barrier(0)
constexpr int TILE_B = 16384;
__device__ __forceinline__ int v_st(int k, int c) { const int kk = (k & ~0xC) | ((k & 4) << 1) | ((k & 8) >> 1); return ((kk >> 3) * 4 + (c >> 5)) * 512 + ((kk & 7) * 32 + (c & 31)) * 2; }
__device__ __forceinline__ int v_rd_base(int lane) { return ((lane & 3) << 3) | (((lane >> 2) & 3) << 6) | (((lane >> 4) & 1) << 5) | (((lane >> 5) & 1) << 8); }
__device__ __forceinline__ int crow(int r, int hi) { return (r & 3) + 8 * (r >> 2) + 4 * hi; }

__device__ __forceinline__ void qkt_acc(f32x16& p0, f32x16& p1, ldsp Kl, int r32, int hi, const bf16x8* qr) {
    ldsp kb[4];
#pragma unroll
    for (int dd = 0; dd < 4; ++dd) kb[dd] = Kl + KSWZ(r32, (dd * 16 + hi * 8) * 2);
#pragma unroll
    for (int d0 = 0; d0 < 8; ++d0) { ldsp a = kb[d0 & 3] + (d0 >> 2) * 128;
        const bf16x8 b0 = *(const LAS bf16x8*)a;
        const bf16x8 b1 = *(const LAS bf16x8*)(a + 32 * 256);
        p0 = __builtin_amdgcn_mfma_f32_32x32x16_bf16(b0, qr[d0], p0, 0, 0, 0);
        p1 = __builtin_amdgcn_mfma_f32_32x32x16_bf16(b1, qr[d0], p1, 0, 0, 0); }
}
__device__ __forceinline__ void pv_tile(f32x16* o, int vb0, bf16x8 pa0, bf16x8 pa1, bf16x8 pa2, bf16x8 pa3) {
#define TRRD(dst, off) asm volatile("ds_read_b64_tr_b16 %0, %1 offset:%2" : "=&v"(dst) : "v"(vb0), "i"(off) : "memory")
#define PV_D0(d0) do { s16x4 l0, l1, l2, l3, h0, h1, h2, h3; constexpr int b_ = (d0) * 512; \
        TRRD(l0, b_); TRRD(h0, b_ + 2048); TRRD(l1, b_ + 4096); TRRD(h1, b_ + 6144); TRRD(l2, b_ + 8192); TRRD(h2, b_ + 10240); TRRD(l3, b_ + 12288); TRRD(h3, b_ + 14336); \
        asm volatile("s_waitcnt lgkmcnt(0)" ::: "memory"); SBAR(); \
        o[d0] = __builtin_amdgcn_mfma_f32_32x32x16_bf16(pa0, (bf16x8){l0[0], l0[1], l0[2], l0[3], h0[0], h0[1], h0[2], h0[3]}, o[d0], 0, 0, 0); \
        o[d0] = __builtin_amdgcn_mfma_f32_32x32x16_bf16(pa1, (bf16x8){l1[0], l1[1], l1[2], l1[3], h1[0], h1[1], h1[2], h1[3]}, o[d0], 0, 0, 0); \
        o[d0] = __builtin_amdgcn_mfma_f32_32x32x16_bf16(pa2, (bf16x8){l2[0], l2[1], l2[2], l2[3], h2[0], h2[1], h2[2], h2[3]}, o[d0], 0, 0, 0); \
        o[d0] = __builtin_amdgcn_mfma_f32_32x32x16_bf16(pa3, (bf16x8){l3[0], l3[1], l3[2], l3[3], h3[0], h3[1], h3[2], h3[3]}, o[d0], 0, 0, 0); } while (0)
    PV_D0(0); PV_D0(1); PV_D0(2); PV_D0(3);
#undef PV_D0
#undef TRRD
}
#define PK4(P, B_, OUT) do { unsigned a0 = cvt_pk_bf16(P[B_+0], P[B_+1]), a1 = cvt_pk_bf16(P[B_+2], P[B_+3]); \
        unsigned b0 = cvt_pk_bf16(P[B_+4], P[B_+5]), b1 = cvt_pk_bf16(P[B_+6], P[B_+7]); \
        auto r0 = __builtin_amdgcn_permlane32_swap(a0, b0, false, false); auto r1 = __builtin_amdgcn_permlane32_swap(a1, b1, false, false); \
        u32x4 w = {r0[0], r1[0], r0[1], r1[1]}; OUT = __builtin_bit_cast(bf16x8, w); } while (0)
__device__ __forceinline__ float pair_max(float v) { auto rr = __builtin_amdgcn_permlane32_swap(__float_as_uint(v), __float_as_uint(v), false, false); return fmaxf(__uint_as_float(rr[0]), __uint_as_float(rr[1])); }
__device__ __forceinline__ float pair_sum(float v) { auto rr = __builtin_amdgcn_permlane32_swap(__float_as_uint(v), __float_as_uint(v), false, false); return __uint_as_float(rr[0]) + __uint_as_float(rr[1]); }

struct Params { const float* in[16]; float* out; unsigned char* ws; };

constexpr int AL_V = 0, AL_K = TILE_B, AL_BUF = 2 * TILE_B  , AL_WS = 4 * TILE_B, AL_LUT = AL_WS + 8192, AL_IMP = AL_LUT + 2048;

template <int MODE>
__device__ __forceinline__ void score_xform(f32x16& p0, f32x16& p1, int tq, int jt, int hi, const LAS float* lut, bool fast, bool selbit) {
    const float NEG = -__builtin_inff();
    if (fast) {
        const float b31 = lut[127];
#pragma unroll
        for (int r = 0; r < 16; ++r) { p0[r] = fmaf(p0[r], QK_C2, b31); p1[r] = fmaf(p1[r], QK_C2, b31); }
        if (MODE == 1) { if (!selbit) {
#pragma unroll
            for (int r = 0; r < 16; ++r) { p0[r] = NEG; p1[r] = NEG; } } }
    } else {
#pragma unroll
        for (int r = 0; r < 16; ++r) {
            const int c = (r & 3) + 8 * (r >> 2) + 4 * hi;
#pragma unroll
            for (int half = 0; half < 2; ++half) {
                const int kk = jt * 64 + half * 32 + c;
                int dist; bool valid;
                if (MODE == 0) { dist = tq - (16 * kk + 31); valid = (dist >= 0) && (kk < 255); }
                else if (MODE == 1) { dist = tq - kk; valid = (dist >= 0) && selbit; }
                else { dist = tq - kk; valid = (unsigned)dist < 512u; }
                int idx = dist < 0 ? 0 : dist; idx = idx > 127 ? 127 : idx;
                const float raw = half ? p1[r] : p0[r];
                float bias = lut[idx]; asm volatile("" : "+v"(bias));
                const float s = valid ? fmaf(raw, QK_C2, bias) : NEG;
                if (half) p1[r] = s; else p0[r] = s;
            }
        }
    }
}

__device__ __forceinline__ void stage_k(ldsp Kl, const bf16_t* g, size_t pitch, int sr, int sc) {
    const bf16x8 a = *(const bf16x8*)(g + (size_t)sr * pitch + sc), b = *(const bf16x8*)(g + (size_t)(sr + 32) * pitch + sc);
    *(LAS bf16x8*)(Kl + KSWZ(sr, sc * 2)) = a; *(LAS bf16x8*)(Kl + KSWZ(sr, sc * 2) + 32 * 256) = b;
}
__device__ __forceinline__ void stage_v(ldsp Vl, const bf16_t* g, size_t pitch, int sr, int sc) {
    const bf16x8 a = *(const bf16x8*)(g + (size_t)sr * pitch + sc), b = *(const bf16x8*)(g + (size_t)(sr + 32) * pitch + sc);
    *(LAS bf16x8*)(Vl + v_st(sr, sc)) = a; *(LAS bf16x8*)(Vl + v_st(sr + 32, sc)) = b;
}

template <int MODE>
__device__ __forceinline__ void attn_unit(const Params& P, ldsp lds, const int tid, int b, int g, int qt) {
    const int wid = __builtin_amdgcn_readfirstlane(tid >> 6), lane = tid & 63; int r32 = lane & 31, hi = lane >> 5;
    asm volatile("" : "+v"(r32), "+v"(hi));
    const int hl = wid >> 1, th = wid & 1, hg = g * 4 + hl;
    const int tq = qt * 64 + th * 32 + r32;
    const size_t rowg = (size_t)b * SEQ + tq;
    const bf16_t* H = (const bf16_t*)(P.ws + WS_H);
    bf16_t* OB = (bf16_t*)(P.ws + WS_OB);
    unsigned long long* SEL = (unsigned long long*)(P.ws + WS_SEL);
    constexpr bool PIPE = (MODE != 0);
    constexpr int WSO = PIPE ? 6 * TILE_B : AL_WS, LUTO = WSO + 8192;
    LAS float* wsf = (LAS float*)(lds + WSO) + wid * 256;
    LAS float* lut = (LAS float*)(lds + LUTO) + hl * 128;
    const int sr = tid >> 4, sc = (tid & 15) * 8;
    __syncthreads();
    {
        const int h4 = tid >> 7, d = tid & 127;
        int bk = d;
        if (d >= 16) { bk = 16 + (int)(logf((float)d * (1.f / 16.f)) * (16.f / 2.0794415416798357f)); bk = bk > 31 ? 31 : bk; }
        ((LAS float*)(lds + LUTO))[h4 * 128 + d] = P.in[1][bk * 8 + g * 4 + h4] * L2E;
    }
    bf16x8 qr[8];
#pragma unroll
    for (int d0 = 0; d0 < 8; ++d0) qr[d0] = *(const bf16x8*)(H + rowg * EVP + C_Q + hg * 128 + d0 * 16 + hi * 8);
    unsigned long long selmask = 0ull;
    if (MODE == 1) selmask = SEL[((size_t)b * 2 + g) * SEQ + tq];
    const bf16_t* Kg; const bf16_t* Vg; size_t pitch;
    if (MODE == 0) { const bf16_t* KC = (const bf16_t*)(P.ws + WS_KCVC); Kg = KC + ((size_t)(0 * 4 + b) * 2 + g) * 256 * 128; Vg = KC + ((size_t)(1 * 4 + b) * 2 + g) * 256 * 128; pitch = 128; }
    else if (MODE == 1) { Kg = H + (size_t)b * SEQ * EVP + C_KS + g * 128; Vg = H + (size_t)b * SEQ * EVP + C_VS + g * 128; pitch = EVP; }
    else { Kg = H + (size_t)b * SEQ * EVP + C_KW + g * 128; Vg = H + (size_t)b * SEQ * EVP + C_VW + g * 128; pitch = EVP; }
    int j_lo = 0, j_hi = qt;
    if (MODE == 0) { j_lo = 0; j_hi = (4 * qt + 2) >> 6; }
    if (MODE == 2) { j_lo = qt - 8 < 0 ? 0 : qt - 8; }
    const int vbase = (int)(unsigned)(size_t)(lds + AL_V) + v_rd_base(lane);
    bf16x8 rk0, rk1, rv0, rv1;
    const size_t go0 = (size_t)sr * pitch + sc, go1 = (size_t)(sr + 32) * pitch + sc;
    const int kso = KSWZ(sr, sc * 2), vso0 = v_st(sr, sc), vso1 = v_st(sr + 32, sc);
#define LOADK(jt_) do { const bf16_t* kp_ = Kg + (size_t)(jt_) * 64 * pitch; rk0 = *(const bf16x8*)(kp_ + go0); rk1 = *(const bf16x8*)(kp_ + go1); } while (0)
#define LOADV(jt_) do { const bf16_t* vp_ = Vg + (size_t)(jt_) * 64 * pitch; rv0 = *(const bf16x8*)(vp_ + go0); rv1 = *(const bf16x8*)(vp_ + go1); } while (0)
#define WRITEK(bf_) do { ldsp kl_ = lds + AL_K + (bf_) * AL_BUF; *(LAS bf16x8*)(kl_ + kso) = rk0; *(LAS bf16x8*)(kl_ + kso + 32 * 256) = rk1; } while (0)
#define WRITEV(bf_) do { ldsp vl_ = lds + AL_V + (bf_) * AL_BUF; *(LAS bf16x8*)(vl_ + vso0) = rv0; *(LAS bf16x8*)(vl_ + vso1) = rv1; } while (0)
    const int tw0 = qt * 64 + th * 32;
    float m_reg = -1e30f, l_reg = 0.f;
    f32x16 o[4];
#pragma unroll
    for (int d = 0; d < 4; ++d) o[d] = (f32x16){0.f};
    f32x16 p0, p1;

    if (MODE == 0) {
        LOADK(j_lo); WRITEK(0); __syncthreads();
        for (int jt = j_lo; jt <= j_hi; ++jt) {
            const int cur = (jt - j_lo) & 1;
            if (jt < j_hi) { LOADK(jt + 1); }
            SBAR();
            p0 = (f32x16){0.f}; p1 = (f32x16){0.f};
            qkt_acc(p0, p1, lds + AL_K + cur * AL_BUF, r32, hi, qr);
            int tql = tq; asm volatile("" : "+v"(tql));
            score_xform<0>(p0, p1, tql, jt, hi, lut, (jt < 3) && ((tw0 - (16 * (jt * 64 + 63) + 31)) >= 128), true);
            float pmax = p0[0];
#pragma unroll
            for (int r = 1; r < 16; ++r) pmax = fmaxf(pmax, p0[r]);
#pragma unroll
            for (int r = 0; r < 16; ++r) pmax = fmaxf(pmax, p1[r]);
            pmax = pair_max(pmax);
            const float mn = fmaxf(m_reg, pmax); const float alpha = __builtin_amdgcn_exp2f(m_reg - mn); m_reg = mn;
            float ps = 0.f;
#pragma unroll
            for (int r = 0; r < 16; ++r) ps += __builtin_amdgcn_exp2f(p0[r] - mn) + __builtin_amdgcn_exp2f(p1[r] - mn);
            ps = pair_sum(ps);
            l_reg = l_reg * alpha + ps;
            if (jt < j_hi) { WRITEK(cur ^ 1); }
            __syncthreads();
        }
    }
    const float inv_l0 = (MODE == 0) ? (l_reg > 0.f ? 1.f / l_reg : 0.f) : 1.f;
    float carry = 0.f;
    bf16x8 pa0, pa1, pa2, pa3;
    unsigned gok[2], gov[2];
#pragma unroll
    for (int i = 0; i < 2; ++i) {
        const int row = i * 32 + (tid >> 4); const int colB = ((tid & 15) * 16) ^ ((row & 7) << 4);
        gok[i] = (unsigned)(row * (int)pitch + (colB >> 1));
        const int stl = i * 16 + (tid >> 5), off = (tid & 31) * 16; const int kk = (stl >> 2) * 8 + (off >> 6);
        const int kx = (kk & ~0xC) | ((kk & 4) << 1) | ((kk & 8) >> 1); const int cx = (stl & 3) * 32 + ((off & 63) >> 1);
        gov[i] = (unsigned)(kx * (int)pitch + cx);
    }
#define DMA_K(tile_, slot_) do { const bf16_t* kp_ = Kg + (size_t)(tile_) * 64 * pitch; _Pragma("unroll") for (int i_ = 0; i_ < 2; ++i_) \
        __builtin_amdgcn_global_load_lds((const unsigned*)(kp_ + gok[i_]), (LAS unsigned*)(lds + (slot_) * TILE_B + wid * 1024 + i_ * 8192), 16, 0, 0); } while (0)
#define DMA_V(tile_, slot_) do { const bf16_t* vp_ = Vg + (size_t)(tile_) * 64 * pitch; _Pragma("unroll") for (int i_ = 0; i_ < 2; ++i_) \
        __builtin_amdgcn_global_load_lds((const unsigned*)(vp_ + gov[i_]), (LAS unsigned*)(lds + (3 + (slot_)) * TILE_B + wid * 1024 + i_ * 8192), 16, 0, 0); } while (0)
    int s0 = 0, s1 = 1, s2 = 2;
    if (PIPE) {
        asm volatile("" :: "v"(qr[0]), "v"(qr[1]), "v"(qr[2]), "v"(qr[3]), "v"(qr[4]), "v"(qr[5]), "v"(qr[6]), "v"(qr[7]), "v"(selmask));
        DMA_K(j_lo, 0); DMA_K(j_lo + 1 > j_hi ? j_hi : j_lo + 1, 1); DMA_V(j_lo, 0);
        asm volatile("s_waitcnt vmcnt(0) lgkmcnt(0)" ::: "memory"); __builtin_amdgcn_s_barrier(); asm volatile("" ::: "memory");
    } else { LOADK(j_lo); LOADV(j_lo); WRITEK(0); WRITEV(0); __syncthreads(); }
    for (int jt = j_lo; jt <= j_hi; ++jt) {
        const int cur = (jt - j_lo) & 1;
        if (PIPE) { DMA_K(jt + 2 > j_hi ? j_hi : jt + 2, s2); DMA_V(jt + 1 > j_hi ? j_hi : jt + 1, s1); }
        else if (jt < j_hi) { LOADK(jt + 1); LOADV(jt + 1); }
        SBAR();
        p0 = (f32x16){0.f}; p1 = (f32x16){0.f};
        qkt_acc(p0, p1, PIPE ? lds + s0 * TILE_B : lds + AL_K + cur * AL_BUF, r32, hi, qr);
        if (PIPE) { if (jt > j_lo) pv_tile(o, vbase + (3 + s2) * TILE_B, pa0, pa1, pa2, pa3); }
        bool fast = false; bool selbit = true;
        if (MODE == 1) { selbit = (selmask >> jt) & 1ull; fast = (tw0 - (jt * 64 + 63)) >= 128; }
        if (MODE == 2) { fast = ((tw0 - (jt * 64 + 63)) >= 128) && ((tw0 + 31 - jt * 64) < 512); }
        int tql = tq; asm volatile("" : "+v"(tql));
        if (MODE == 0) score_xform<0>(p0, p1, tql, jt, hi, lut, (jt < 3) && ((tw0 - (16 * (jt * 64 + 63) + 31)) >= 128), true);
        else if (!fast) score_xform<MODE>(p0, p1, tql, jt, hi, lut, false, selbit);
        if (MODE == 0) {
#pragma unroll
            for (int r = 0; r < 16; ++r) { p0[r] = __builtin_amdgcn_exp2f(p0[r] - m_reg) * inv_l0; p1[r] = __builtin_amdgcn_exp2f(p1[r] - m_reg) * inv_l0; }
#pragma unroll
            for (int half = 0; half < 2; ++half) {
                float A[4], Bq[4], pB[4];
#pragma unroll
                for (int q = 0; q < 4; ++q) { const float x0 = half ? p1[4 * q] : p0[4 * q], x1 = half ? p1[4 * q + 1] : p0[4 * q + 1], x2 = half ? p1[4 * q + 2] : p0[4 * q + 2], x3 = half ? p1[4 * q + 3] : p0[4 * q + 3];
                    A[q] = (x0 + x1) + (x2 + x3); Bq[q] = x3; }
#pragma unroll
                for (int q = 0; q < 4; ++q) pB[q] = __shfl_xor(Bq[q], 32);
                if (hi) {
#pragma unroll
                    for (int q = 0; q < 4; ++q) A[q] += pB[q];
                } else { A[0] += carry; A[1] += pB[0]; A[2] += pB[1]; A[3] += pB[2]; carry = pB[3]; }
                LAS float* slab = (LAS float*)(lds + AL_IMP) + ((hl * 64 + th * 32 + r32) * 64) + 16 * jt + 8 * half + hi;
#pragma unroll
                for (int q = 0; q < 4; ++q) slab[2 * q] = A[q];
            }
        } else {
            float pmax = p0[0];
#pragma unroll
            for (int r = 1; r < 16; ++r) pmax = fmaxf(pmax, p0[r]);
#pragma unroll
            for (int r = 0; r < 16; ++r) pmax = fmaxf(pmax, p1[r]);
            pmax = pair_max(pmax);
            const float NEGI = -__builtin_inff();
            float boff = 0.f;
            if (fast) { boff = lut[127]; pmax = fmaf(pmax, QK_C2, boff); if (MODE == 1 && !selbit) { pmax = NEGI; boff = NEGI; } }
            float mn, alpha;
            if (__all(pmax - m_reg <= 8.f)) { mn = m_reg; alpha = 1.f; }
            else { mn = fmaxf(m_reg, pmax); alpha = __builtin_amdgcn_exp2f(m_reg - mn); m_reg = mn; }
            float ps = 0.f;
            if (fast) { const float off = boff - mn;
#pragma unroll
                for (int r = 0; r < 16; ++r) { p0[r] = __builtin_amdgcn_exp2f(fmaf(p0[r], QK_C2, off)); p1[r] = __builtin_amdgcn_exp2f(fmaf(p1[r], QK_C2, off)); ps += p0[r] + p1[r]; }
            } else {
#pragma unroll
                for (int r = 0; r < 16; ++r) { p0[r] = __builtin_amdgcn_exp2f(p0[r] - mn); p1[r] = __builtin_amdgcn_exp2f(p1[r] - mn); ps += p0[r] + p1[r]; }
            }
            ps = pair_sum(ps);
            l_reg = l_reg * alpha + ps;
            if (__any(alpha < 1.f)) {
                if (hi == 0) wsf[r32] = alpha;
#pragma unroll
                for (int r = 0; r < 16; ++r) { const float a = wsf[crow(r, hi)];
#pragma unroll
                    for (int d = 0; d < 4; ++d) o[d][r] *= a; }
            }
        }
        PK4(p0, 0, pa0); PK4(p0, 8, pa1); PK4(p1, 0, pa2); PK4(p1, 8, pa3);
        if (PIPE) {
            asm volatile("s_waitcnt vmcnt(4) lgkmcnt(0)" ::: "memory"); __builtin_amdgcn_s_barrier(); asm volatile("" ::: "memory");
            const int t_ = s0; s0 = s1; s1 = s2; s2 = t_;
        } else {
            pv_tile(o, vbase + cur * AL_BUF, pa0, pa1, pa2, pa3);
            if (jt < j_hi) { WRITEK(cur ^ 1); WRITEV(cur ^ 1); }
            __syncthreads();
        }
    }
    if (PIPE) { pv_tile(o, vbase + (3 + s2) * TILE_B, pa0, pa1, pa2, pa3); asm volatile("s_waitcnt vmcnt(0)" ::: "memory"); }
#undef DMA_K
#undef DMA_V
#undef LOADK
#undef LOADV
#undef WRITEK
#undef WRITEV

    asm volatile("" : "+v"(r32), "+v"(hi));
    int ln = lane; asm volatile("" : "+v"(ln));
    if (PIPE) __syncthreads();
    ldsp ost = lds + wid * 8192;
    if (MODE == 2) { if (hi == 0) wsf[r32] = l_reg > 0.f ? 1.f / l_reg : 0.f; }
    if (MODE == 1) {
        if (hi == 0) {
            const bf16_t* gp = H + rowg * EVP + C_GATE + hg;
            const float g0 = sigmoid_f(bf2f(gp[0])), g1 = sigmoid_f(bf2f(gp[8])), g2 = sigmoid_f(bf2f(gp[16]));
            wsf[r32] = g1 * (l_reg > 0.f ? 1.f / l_reg : 0.f); wsf[32 + r32] = g0; wsf[64 + r32] = g2;
        }
    }
#pragma unroll
    for (int r = 0; r < 16; ++r) { const int row = crow(r, hi);
#pragma unroll
        for (int d = 0; d < 4; ++d) *(LAS unsigned short*)(ost + row * 256 + (d * 32 + r32) * 2) = (unsigned short)(cvt_pk_bf16(o[d][r], 0.f) & 0xffffu); }
    {
        const size_t trow = (size_t)b * SEQ + tw0;
        bf16_t* MIX = (bf16_t*)(P.ws + WS_XB);
#pragma unroll
        for (int i = 0; i < 8; ++i) { const int row = i * 4 + (ln >> 4), c8 = (ln & 15) * 8;
            const bf16x8 ov = *(const LAS bf16x8*)(ost + row * 256 + c8 * 2);
            if (MODE == 0) { *(bf16x8*)(OB + (trow + row) * 1024 + hg * 128 + c8) = ov; }
            else if (MODE == 2) { float f[8]; unpack8(ov, f); const float a = wsf[row];
                *(bf16x8*)(OB + (size_t)MTOK * 1024 + (trow + row) * 1024 + hg * 128 + c8) = pack8((f32x4){f[0] * a, f[1] * a, f[2] * a, f[3] * a}, (f32x4){f[4] * a, f[5] * a, f[6] * a, f[7] * a}); }
            else { float f[8], oc[8], ow[8], bz[8]; unpack8(ov, f);
                unpack8(*(const bf16x8*)(OB + (trow + row) * 1024 + hg * 128 + c8), oc);
                unpack8(*(const bf16x8*)(OB + (size_t)MTOK * 1024 + (trow + row) * 1024 + hg * 128 + c8), ow);
                unpack8(*(const bf16x8*)(H + (trow + row) * EVP + C_BZ + hg * 128 + c8), bz);
                const float as = wsf[row], gc = wsf[32 + row], gw = wsf[64 + row];
                float y[8];
#pragma unroll
                for (int e = 0; e < 8; ++e) y[e] = (gc * oc[e] + as * f[e] + gw * ow[e]) * silu_f(bz[e]);
                *(bf16x8*)(MIX + (trow + row) * DM + 1024 + hg * 128 + c8) = pack8((f32x4){y[0], y[1], y[2], y[3]}, (f32x4){y[4], y[5], y[6], y[7]}); }
        }
    }
    if (MODE == 0) {
        __syncthreads();
        const LAS float* imp = (const LAS float*)(lds + AL_IMP);
        for (int i = 0; i < 8; ++i) {
            const int tok = wid * 8 + i;
            float v = (imp[(0 * 64 + tok) * 64 + lane] + imp[(1 * 64 + tok) * 64 + lane]) + (imp[(2 * 64 + tok) * 64 + lane] + imp[(3 * 64 + tok) * 64 + lane]);
            if (lane > qt) v = -1.f;
            else if (lane == 0 || lane == qt || lane == qt - 1) v = 1e9f;
            int rank = 0;
#pragma unroll 8
            for (int j = 0; j < 64; ++j) { const float vj = __uint_as_float(__builtin_amdgcn_readlane(__float_as_uint(v), j)); rank += (vj > v || (vj == v && j < lane)) ? 1 : 0; }
            const unsigned long long msk = __ballot((rank < 16) && (lane <= qt));
            if (lane == 0) SEL[((size_t)b * 2 + g) * SEQ + qt * 64 + tok] = msk;
        }
    }
}

__device__ __forceinline__ void qkt_acc32(f32x16& p0, ldsp Kl, int r32, int hi, const bf16x8* qr) {
    ldsp kb[4];
#pragma unroll
    for (int dd = 0; dd < 4; ++dd) kb[dd] = Kl + KSWZ(r32, (dd * 16 + hi * 8) * 2);
#pragma unroll
    for (int d0 = 0; d0 < 8; ++d0) { const bf16x8 b0 = *(const LAS bf16x8*)(kb[d0 & 3] + (d0 >> 2) * 128);
        p0 = __builtin_amdgcn_mfma_f32_32x32x16_bf16(b0, qr[d0], p0, 0, 0, 0); }
}
__device__ __forceinline__ void compress_unit(const Params& P, ldsp lds, const int tid, int li, int kv, int b, int g, int mt) {
    const int wid = __builtin_amdgcn_readfirstlane(tid >> 6), lane = tid & 63, r32 = lane & 31, hi = lane >> 5;
    const int cg4 = wid & 3, sl = wid >> 2;
    const int sr = tid >> 4, sc = (tid & 15) * 8;
    const bf16_t* H = (const bf16_t*)(P.ws + WS_H);
    const bf16_t* W1t = (const bf16_t*)(P.ws + WS_W1T) + (size_t)(li * 2 + kv) * 128 * 4096;
    const bf16_t* W2t = (const bf16_t*)(P.ws + WS_W2T) + (size_t)(li * 2 + kv) * 128 * 128;
    const float* pos = P.in[6] + (size_t)(li * 2 + kv) * 32 * 128;
    const int col0 = (kv ? C_VC : C_KC) + g * 128;
    f32x16 p0 = (f32x16){0.f};
    for (int it = 0; it < 16; ++it) {
        bf16x8 wq[8];
#pragma unroll
        for (int d0 = 0; d0 < 8; ++d0) wq[d0] = *(const bf16x8*)(W1t + ((size_t)((2 * it + sl) * 8 + d0) * 128 + (cg4 * 32 + r32)) * 16 + hi * 8);
        __syncthreads();
#pragma unroll
        for (int s = 0; s < 2; ++s) { const int l = 2 * it + s;
            const f32x4 q0 = *(const f32x4*)(pos + l * 128 + sc), q1 = *(const f32x4*)(pos + l * 128 + sc + 4);
            int tok = 16 * (mt * 32 + sr) + l; tok = tok > SEQ - 1 ? SEQ - 1 : tok;
            const bf16x8 tv = *(const bf16x8*)(H + ((size_t)b * SEQ + tok) * EVP + col0 + sc);
            float f[8]; unpack8(tv, f);
            const f32x4 a = {f[0] + q0[0], f[1] + q0[1], f[2] + q0[2], f[3] + q0[3]}, c = {f[4] + q1[0], f[5] + q1[1], f[6] + q1[2], f[7] + q1[3]};
            *(LAS bf16x8*)(lds + s * TILE_B + KSWZ(sr, sc * 2)) = pack8(a, c); }
        __syncthreads();
        qkt_acc32(p0, lds + sl * TILE_B, r32, hi, wq);
    }
    __syncthreads();
    LAS float* part = (LAS float*)(lds + 2 * TILE_B);
    if (sl == 1) {
#pragma unroll
        for (int r = 0; r < 16; ++r) part[crow(r, hi) * 128 + cg4 * 32 + r32] = p0[r];
    }
    __syncthreads();
    ldsp hid = lds + 4 * TILE_B;
    if (sl == 0) {
#pragma unroll
        for (int r = 0; r < 16; ++r) { const int ra = crow(r, hi), col = cg4 * 32 + r32;
            const float xa = silu_f(p0[r] + part[ra * 128 + col]);
            *(LAS unsigned short*)(hid + KSWZ(ra, col * 2)) = (unsigned short)(cvt_pk_bf16(xa, 0.f) & 0xffffu); }
    }
    __syncthreads();
    if (sl == 0) {
        bf16x8 wq[8];
#pragma unroll
        for (int d0 = 0; d0 < 8; ++d0) wq[d0] = *(const bf16x8*)(W2t + (size_t)(cg4 * 32 + r32) * 128 + d0 * 16 + hi * 8);
        f32x16 y0 = (f32x16){0.f};
        qkt_acc32(y0, hid, r32, hi, wq);
        bf16_t* KC = (bf16_t*)(P.ws + WS_KCVC) + (((size_t)(kv * 4 + b) * 2 + g) * 256 + mt * 32) * 128;
#pragma unroll
        for (int r = 0; r < 16; ++r) { const int ra = crow(r, hi), col = cg4 * 32 + r32;
            KC[(size_t)ra * 128 + col] = (bf16_t)(cvt_pk_bf16(y0[r], 0.f) & 0xffffu); }
    }
}

__device__ __forceinline__ void sgu_unit(const Params& P, ldsp lds, const int tid, int li, int b, int ch, int g) {
    const int wid = __builtin_amdgcn_readfirstlane(tid >> 6), lane = tid & 63, r32 = lane & 31, hi = lane >> 5;
    const bf16_t* UVZ = (const bf16_t*)(P.ws + WS_H);
    bf16_t* Y = (bf16_t*)(P.ws + WS_XB);
    const size_t row0 = (size_t)b * SEQ + (size_t)ch * 128;
    const float* stats = (const float*)(P.ws + WS_STATS) + row0 * 2;
    __syncthreads();
    const float* gam = P.in[11] + (size_t)li * 2048 + g * 256; const float* bet = P.in[12] + (size_t)li * 2048 + g * 256;
#pragma unroll
    for (int it = 0; it < 8; ++it) { const int idx = tid + 512 * it; const int s = idx >> 5, cv = (idx & 31) * 8;
        const bf16x8 vv = *(const bf16x8*)(UVZ + (row0 + s) * ODP + 2048 + g * 256 + cv);
        float f[8]; unpack8(vv, f);
        const float mean = stats[s * 2] * (1.f / 2048.f); const float rstd = 1.f / sqrtf(fmaxf(stats[s * 2 + 1] * (1.f / 2048.f) - mean * mean, 0.f) + LN_EPS);
        const f32x4 g0 = *(const f32x4*)(gam + cv), g1 = *(const f32x4*)(gam + cv + 4), b0 = *(const f32x4*)(bet + cv), b1 = *(const f32x4*)(bet + cv + 4);
        f32x4 a, c;
#pragma unroll
        for (int e = 0; e < 4; ++e) { a[e] = (f[e] - mean) * rstd * g0[e] + b0[e]; c[e] = (f[4 + e] - mean) * rstd * g1[e] + b1[e]; }
        *(LAS bf16x8*)(lds + ((s >> 6) * 2 + (cv >> 7)) * TILE_B + v_st(s & 63, cv & 127)) = pack8(a, c); }
    __syncthreads();
    const int rt = wid & 3, chh = wid >> 2;
    const int t = rt * 32 + r32;
    const bf16x8* WF = (const bf16x8*)(P.ws + WS_SGW) + ((size_t)((li * 8 + g) * 4 + rt) * 2) * 4 * 64 + lane;
    f32x16 o[4];
#pragma unroll
    for (int d = 0; d < 4; ++d) o[d] = (f32x16){0.f};
    for (int st = 0; st < 2; ++st) {
        if (st * 64 > rt * 32 + 31) break;
        bf16x8 pa[4];
#pragma unroll
        for (int i = 0; i < 4; ++i) pa[i] = WF[(st * 4 + i) * 64];
        const int vb0 = (int)(unsigned)(size_t)(lds + (st * 2 + chh) * TILE_B) + v_rd_base(lane);
        pv_tile(o, vb0, pa[0], pa[1], pa[2], pa[3]);
    }
    const float* sb = P.in[14] + (size_t)(li * 8 + g) * 128;
    ldsp mx = lds + 4 * TILE_B;
#pragma unroll
    for (int r = 0; r < 16; ++r) { const int tt = rt * 32 + crow(r, hi); const float bias = sb[tt];
#pragma unroll
        for (int d = 0; d < 4; ++d) { const int col = chh * 128 + d * 32 + r32;
            *(LAS unsigned short*)(mx + tt * 512 + col * 2) = (unsigned short)(cvt_pk_bf16(o[d][r] + bias, 0.f) & 0xffffu); } }
    __syncthreads();
#pragma unroll
    for (int it = 0; it < 8; ++it) { const int idx = tid + 512 * it; const int tt = idx >> 5, cv = (idx & 31) * 8;
        const bf16_t* up = UVZ + (row0 + tt) * ODP + g * 256 + cv;
        float fu[8], fm[8];
        unpack8(*(const bf16x8*)up, fu); unpack8(*(const LAS bf16x8*)(mx + tt * 512 + cv * 2), fm);
        f32x4 a, c;
#pragma unroll
        for (int e = 0; e < 4; ++e) { a[e] = fu[e] * fm[e]; c[e] = fu[4 + e] * fm[4 + e]; }
        *(bf16x8*)(Y + (row0 + tt) * DM + g * 256 + cv) = pack8(a, c); }
}

struct TItem { const float* src; bf16_t* dst; int Nsrc, K, nvalid, alt; bf16_t* wtb; int n0, k0, frag; };
constexpr int I_EV = (DM / 64) * (EVN / 32), I_OD = (DM / 64) * (ODN / 32), I_WO = (DM / 64) * (DM / 32), I_W1 = (4096 / 64) * (128 / 32), I_W2 = (128 / 64) * (128 / 32);
constexpr int NIT_ALL = I_EV + 2 * I_OD + 4 * I_WO + 4 * I_W1 + 4 * I_W2;
__device__ __forceinline__ TItem t_plain(const float* W, int K, int N, bf16_t* WT, int item) {
    const int nblk = N / 32, kb = item / nblk, nb = item % nblk;
    TItem t; t.src = W + (size_t)(kb * 64) * N + nb * 32; t.dst = WT + (size_t)(nb * 32) * K + kb * 64; t.Nsrc = N; t.K = K; t.nvalid = 32; t.alt = 0; t.wtb = WT; t.n0 = nb * 32; t.k0 = kb * 64; t.frag = 0; return t;
}
__device__ __forceinline__ TItem t_ev(const float* W, bf16_t* WT, int item) {
    const int nblk = EVN / 32, kb = item / nblk, nb = item % nblk, n0 = nb * 32;
    int n0src, nvalid, alt = 0;
    if (n0 < 4096) { const int pn = n0 >> 8, bj = (n0 >> 7) & 1, wc = (n0 >> 5) & 3;
        n0src = (pn < 8 ? 0 : 1024) + (pn & 7) * 128 + wc * 32 + bj * 4; nvalid = 32; alt = 2048; }
    else if (n0 < 6656) { n0src = n0; nvalid = 32; } else if (n0 < 7680) { n0src = n0 + 24; nvalid = 32; } else if (n0 == 7680) { n0src = 6656; nvalid = 24; } else { n0src = 0; nvalid = 0; }
    TItem t; t.src = W + (size_t)(kb * 64) * 7704 + n0src; t.dst = WT + (size_t)n0 * DM + kb * 64; t.Nsrc = 7704; t.K = DM; t.nvalid = nvalid; t.alt = alt; t.wtb = WT; t.n0 = n0; t.k0 = kb * 64; t.frag = 0; return t;
}
__device__ __forceinline__ TItem t_od(const float* W, bf16_t* WT, int item) {
    const int nblk = ODN / 32, kb = item / nblk, nb = item % nblk, n0 = nb * 32;
    TItem t; t.dst = WT + (size_t)n0 * DM + kb * 64; t.Nsrc = ODN; t.K = DM; t.nvalid = 32; t.wtb = WT; t.n0 = n0; t.k0 = kb * 64; t.frag = 0;
    if (n0 < 4096) { const int pn = n0 >> 8, bj = (n0 >> 7) & 1, wc = (n0 >> 5) & 3; t.src = W + (size_t)(kb * 64) * ODN + pn * 128 + wc * 32 + bj * 4; t.alt = 4096; }   else { t.src = W + (size_t)(kb * 64) * ODN + 2048 + (n0 - 4096); t.alt = 0; }
    return t;
}
constexpr int IT_P0_END = I_EV + 4 * I_W1 + 4 * I_W2;
constexpr int IT_SLOT = I_OD + 2 * I_WO;
static_assert(IT_P0_END + 2 * IT_SLOT == NIT_ALL, "item map");
template <bool EVONLY>
__device__ __forceinline__ TItem t_decode(const Params& P, int li_ev, int it) {
    unsigned char* ws = P.ws;
    if (EVONLY || it < I_EV) return t_ev(P.in[4] + (size_t)li_ev * DM * 7704, (bf16_t*)(ws + WS_WEV), it);
    int r = it - I_EV;
    if (r < 4 * I_W1) { const int l = r / I_W1; TItem t = t_plain(P.in[7] + (size_t)l * 4096 * 128, 4096, 128, (bf16_t*)(ws + WS_W1T) + (size_t)l * 128 * 4096, r % I_W1); t.frag = 1; return t; } r -= 4 * I_W1;
    if (r < 4 * I_W2) { const int l = r / I_W2; return t_plain(P.in[8] + (size_t)l * 128 * 128, 128, 128, (bf16_t*)(ws + WS_W2T) + (size_t)l * 128 * 128, r % I_W2); } r -= 4 * I_W2;
    const int l = r / IT_SLOT; r -= l * IT_SLOT;
    if (r < I_OD) return t_od(P.in[10] + (size_t)l * DM * ODN, (bf16_t*)(ws + WS_WOD) + (size_t)l * ODN * DM, r);
    r -= I_OD;
    if (r < I_WO) return t_plain(P.in[9] + (size_t)l * DM * DM, DM, DM, (bf16_t*)(ws + WS_WOUT) + (size_t)l * DM * DM, r);
    r -= I_WO;
    return t_plain(P.in[15] + (size_t)l * DM * DM, DM, DM, (bf16_t*)(ws + WS_WOUT) + (size_t)(2 + l) * DM * DM, r);
}
template <bool EVONLY>
__device__ __forceinline__ void convert_loop(const Params& P, ldsp lds, int li_ev, int gw, int NGW, int wid, int lane, int it_lo = 0, int it_hi = -1) {
    LAS float* scr = (LAS float*)(lds + wid * 16384);
    const int NIT = it_hi >= 0 ? it_hi : (EVONLY ? I_EV : NIT_ALL);
    int it = it_lo + gw; if (it >= NIT) return;
    TItem cur = t_decode<EVONLY>(P, li_ev, it);
    float r[32];
    const int n = lane & 31, kh = lane >> 5;
#pragma unroll
    for (int i = 0; i < 32; ++i) r[i] = (n < cur.nvalid) ? cur.src[(size_t)(2 * i + kh) * cur.Nsrc + (cur.alt ? 8 * (n >> 3) + ((n >> 1) & 3) + (n & 1) * cur.alt : n)] : 0.f;
    for (;;) {
#pragma unroll
        for (int i = 0; i < 32; ++i) scr[(2 * i + kh) * 33 + n] = r[i];
        const int nit = it + NGW; const bool has = nit < NIT;
        TItem nxt = cur;
        if (has) { nxt = t_decode<EVONLY>(P, li_ev, nit);
#pragma unroll
            for (int i = 0; i < 32; ++i) r[i] = (n < nxt.nvalid) ? nxt.src[(size_t)(2 * i + kh) * nxt.Nsrc + (nxt.alt ? 8 * (n >> 3) + ((n >> 1) & 3) + (n & 1) * nxt.alt : n)] : 0.f; }
        asm volatile("s_waitcnt lgkmcnt(0)" ::: "memory");
        const int c = lane & 7;
#pragma unroll
        for (int j = 0; j < 4; ++j) { const int nn = (lane >> 3) + 8 * j; const LAS float* s = scr + (8 * c) * 33 + nn;
            u32x4 o; o.x = cvt_pk_bf16(s[0 * 33], s[1 * 33]); o.y = cvt_pk_bf16(s[2 * 33], s[3 * 33]); o.z = cvt_pk_bf16(s[4 * 33], s[5 * 33]); o.w = cvt_pk_bf16(s[6 * 33], s[7 * 33]);
            bf16_t* dp = cur.frag ? cur.wtb + ((size_t)(((cur.k0 + 8 * c) >> 4) * 128 + cur.n0 + nn) * 16 + ((cur.k0 + 8 * c) & 15)) : cur.dst + (size_t)nn * cur.K + 8 * c;
            *(u32x4*)dp = o; }
        asm volatile("s_waitcnt lgkmcnt(0)" ::: "memory");
        if (!has) break;
        cur = nxt; it = nit;
    }
}

template <bool FINAL>
__device__ __forceinline__ void ln_phase(const float* gam, const float* bet, const float* xres, const bf16_t* Y, float* XF, bf16_t* XB, int gw, int NGW, int lane) {
    for (int row = gw; row < MTOK; row += 2 * NGW) {
        const int row2 = row + NGW; const bool has2 = row2 < MTOK; const int rb = has2 ? row2 : row;
        const f32x4* xa = (const f32x4*)(xres + (size_t)row * DM) + lane; const u32x2* ya = (const u32x2*)(Y + (size_t)row * DM) + lane;
        const f32x4* xb = (const f32x4*)(xres + (size_t)rb * DM) + lane;  const u32x2* yb = (const u32x2*)(Y + (size_t)rb * DM) + lane;
        f32x4 va[8], vb[8]; u32x2 wa[8], wb[8];
#pragma unroll
        for (int j = 0; j < 8; ++j) { va[j] = xa[64 * j]; wa[j] = ya[64 * j]; vb[j] = xb[64 * j]; wb[j] = yb[64 * j]; }
        float sa = 0.f, sb = 0.f;
#pragma unroll
        for (int j = 0; j < 8; ++j) {
            const f32x4 fa = {__uint_as_float(wa[j].x << 16), __uint_as_float(wa[j].x & 0xffff0000u), __uint_as_float(wa[j].y << 16), __uint_as_float(wa[j].y & 0xffff0000u)};
            const f32x4 fb = {__uint_as_float(wb[j].x << 16), __uint_as_float(wb[j].x & 0xffff0000u), __uint_as_float(wb[j].y << 16), __uint_as_float(wb[j].y & 0xffff0000u)};
            va[j] = va[j] * DN_ALPHA + fa; vb[j] = vb[j] * DN_ALPHA + fb;
            sa += (va[j][0] + va[j][1]) + (va[j][2] + va[j][3]); sb += (vb[j][0] + vb[j][1]) + (vb[j][2] + vb[j][3]); }
#pragma unroll
        for (int o = 1; o < 64; o <<= 1) { sa += __shfl_xor(sa, o); sb += __shfl_xor(sb, o); }
        const float ma = sa * (1.f / DM), mb = sb * (1.f / DM); float qa = 0.f, qb = 0.f;
#pragma unroll
        for (int j = 0; j < 8; ++j) { va[j] = va[j] - ma; vb[j] = vb[j] - mb;
            qa += (va[j][0] * va[j][0] + va[j][1] * va[j][1]) + (va[j][2] * va[j][2] + va[j][3] * va[j][3]);
            qb += (vb[j][0] * vb[j][0] + vb[j][1] * vb[j][1]) + (vb[j][2] * vb[j][2] + vb[j][3] * vb[j][3]); }
#pragma unroll
        for (int o = 1; o < 64; o <<= 1) { qa += __shfl_xor(qa, o); qb += __shfl_xor(qb, o); }
        const float ra = 1.f / sqrtf(qa * (1.f / DM) + LN_EPS), rbs = 1.f / sqrtf(qb * (1.f / DM) + LN_EPS);
        f32x4* oa = (f32x4*)(XF + (size_t)row * DM) + lane; u32x2* ba = (u32x2*)(XB + (size_t)row * DM) + lane;
        f32x4* ob = (f32x4*)(XF + (size_t)rb * DM) + lane;  u32x2* bb = (u32x2*)(XB + (size_t)rb * DM) + lane;
#pragma unroll
        for (int j = 0; j < 8; ++j) { const f32x4 g4 = *((const f32x4*)gam + 64 * j + lane), b4 = *((const f32x4*)bet + 64 * j + lane);
            const f32x4 y1 = va[j] * ra * g4 + b4, y2 = vb[j] * rbs * g4 + b4;
            oa[64 * j] = y1; if (has2) ob[64 * j] = y2;
            if (!FINAL) { u32x2 w; w.x = cvt_pk_bf16(y1[0], y1[1]); w.y = cvt_pk_bf16(y1[2], y1[3]); ba[64 * j] = w;
                          if (has2) { u32x2 w2; w2.x = cvt_pk_bf16(y2[0], y2[1]); w2.y = cvt_pk_bf16(y2[2], y2[3]); bb[64 * j] = w2; } } }
    }
}

#define XB_TMO      128
#define XB_XCNT(j)  (256  + 64 * (j))
#define XB_XSUB(j)  (1280 + 64 * (j))
#define XB_XGEN(j)  (2304 + 64 * (j))
#define XB_TOP      3328
#define XB_TOPGEN   3392
#define XCD_BAR_WORDS 3456
#define XB_SPIN_CAP (1u << 18)
__device__ __forceinline__ unsigned xb_ld(unsigned* p)              { return __hip_atomic_load(p, __ATOMIC_RELAXED, __HIP_MEMORY_SCOPE_AGENT); }
__device__ __forceinline__ unsigned xb_add(unsigned* p, unsigned v) { return __hip_atomic_fetch_add(p, v, __ATOMIC_RELAXED, __HIP_MEMORY_SCOPE_AGENT); }
__device__ __forceinline__ unsigned xb_xcc_id() { return (unsigned)__builtin_amdgcn_s_getreg((3 << 11) | 20) & 0xFu; }
#define XB_SPIN(cond, bar) do { unsigned _sp = 0; while (cond) { __builtin_amdgcn_s_sleep(1); \
    if ((++_sp & 255u) == 0u) { if (xb_ld(&(bar)[XB_TMO])) break; if (_sp > XB_SPIN_CAP) { atomicAdd(&(bar)[XB_TMO], 1u); break; } } } } while (0)
struct XcdBarrier { unsigned* bar; unsigned x; volatile LAS unsigned* st; };
__device__ __forceinline__ XcdBarrier xcd_barrier_post(unsigned* bar, volatile LAS unsigned* st) {
    XcdBarrier b; b.bar = bar; b.x = xb_xcc_id(); b.st = st;
    if (threadIdx.x == 0) (void)xb_add(&bar[XB_XCNT(b.x)], 1u);
    return b;
}
__device__ __forceinline__ void xcd_barrier_complete(unsigned* bar, unsigned x, unsigned& nloc, unsigned& nx) {
    const unsigned G = gridDim.x * gridDim.y * gridDim.z;
    unsigned sum, cnt, mine, sp = 0u;
    for (;;) {
        sum = 0u; cnt = 0u; mine = 0u;
#pragma unroll
        for (unsigned j = 0; j < 16; ++j) { const unsigned c = xb_ld(&bar[XB_XCNT(j)]); sum += c; cnt += (c > 0u) ? 1u : 0u; mine = (j == x) ? c : mine; }
        if (sum == G) break;
        __builtin_amdgcn_s_sleep(1);
        if ((++sp & 255u) == 0u) { if (xb_ld(&bar[XB_TMO])) break; if (sp > XB_SPIN_CAP) { atomicAdd(&bar[XB_TMO], 1u); break; } }
    }
    nloc = mine > 0u ? mine : 1u; nx = cnt > 0u ? cnt : 1u;
}
__device__ __forceinline__ void xcd_barrier(const XcdBarrier& b) {
    asm volatile("s_waitcnt vmcnt(0)" ::: "memory");
    __syncthreads();
    if (threadIdx.x == 0) {
        unsigned* bar = b.bar;
        __builtin_amdgcn_s_waitcnt(0);
        unsigned nloc = b.st[0], nx = b.st[1];
        if (nloc == 0u) { xcd_barrier_complete(bar, b.x, nloc, nx); b.st[0] = nloc; b.st[1] = nx; }
        const unsigned old = xb_add(&bar[XB_XSUB(b.x)], 1u);
        const unsigned gen = old / nloc;
        if (old + 1u == (gen + 1u) * nloc) {
            __builtin_amdgcn_fence(__ATOMIC_RELEASE, "agent");
            asm volatile("s_waitcnt vmcnt(0)" ::: "memory");
            const unsigned og = xb_add(&bar[XB_TOP], 1u);
            const unsigned tg = og / nx;
            if (og + 1u == (tg + 1u) * nx) xb_add(&bar[XB_TOPGEN], 1u);
            else XB_SPIN(xb_ld(&bar[XB_TOPGEN]) == tg, bar);
            __builtin_amdgcn_fence(__ATOMIC_ACQUIRE, "agent");
            xb_add(&bar[XB_XGEN(b.x)], 1u);
            asm volatile("s_waitcnt vmcnt(0)" ::: "memory");
        } else {
            XB_SPIN(xb_ld(&bar[XB_XGEN(b.x)]) == gen, bar);
            __builtin_amdgcn_fence(__ATOMIC_ACQUIRE, "agent");
            asm volatile("s_waitcnt vmcnt(0)" ::: "memory");
        }
    }
    __syncthreads();
}
constexpr size_t WS_BAR = 16384;
constexpr size_t CTL_ZERO_BYTES = 65536;
constexpr int LDS_ST_OFF = 147456 - 64;

constexpr int LDS_BYTES = 147456;
static_assert(AL_IMP + 65536 <= LDS_BYTES, "attention LDS map");
#ifndef PH_MASK
#define PH_MASK 0xFFFF
#endif
#define PH_ON(n) (((PH_MASK) >> (n)) & 1)
#ifndef DUP_MASK
#define DUP_MASK 0
#endif
#if DUP_MASK
#define DUPLOOP(n) _Pragma("unroll") for (int dup_ = 0; dup_ < 1 + (((DUP_MASK) >> (n)) & 1) * (layer_dup_ok); ++dup_)
#else
#define DUPLOOP(n)
#endif
#define CAS __attribute__((address_space(4)))
#define KIN_(i) Pz.in[i] = (const float*)(*(GAS const float* const CAS*)(kp_ + 8 * (i)));
#define PHASE_BEGIN() \
    const CAS unsigned char* kp_ = (const CAS unsigned char*)__builtin_amdgcn_kernarg_segment_ptr(); asm volatile("" : "+s"(kp_)); \
    Params Pz; KIN_(0) KIN_(1) KIN_(2) KIN_(3) KIN_(4) KIN_(5) KIN_(6) KIN_(7) KIN_(8) KIN_(9) KIN_(10) KIN_(11) KIN_(12) KIN_(13) KIN_(14) KIN_(15) \
    float* XF = (float*)(*(GAS float* const CAS*)(kp_ + 128)); unsigned char* ws = (unsigned char*)(*(GAS unsigned char* const CAS*)(kp_ + 136)); \
    Pz.ws = ws; Pz.out = XF; \
    int lz_ = 0; asm volatile("" : "+s"(lz_)); \
    ldsp lds = (ldsp)lds_raw + lz_; \
    int tid = (int)threadIdx.x; asm volatile("" : "+v"(tid)); \
    int G = (int)gridDim.x, bx = (int)blockIdx.x; asm volatile("" : "+s"(G), "+s"(bx)); \
    const int wid = __builtin_amdgcn_readfirstlane(tid >> 6), lane = tid & 63; \
    const int gw = bx * 8 + wid, NGW = G * 8; \
    bf16_t* XB = (bf16_t*)(ws + WS_XB); bf16_t* H = (bf16_t*)(ws + WS_H); \
    (void)lane; (void)gw; (void)NGW; (void)XB; (void)H; (void)XF; (void)lds; (void)wid;
static_assert(sizeof(Params) == 144, "kernarg layout");

template <int layer>
__device__ __forceinline__ void layer_body(unsigned char* lds_raw, const XcdBarrier& xbar, int layer_dup_ok) {
#define GRID_SYNC() xcd_barrier(xbar)
        constexpr int li = layer >> 1; (void)layer_dup_ok;
        if ((layer & 1) == 0) {
            DUPLOOP(1) if (PH_ON(1)) { PHASE_BEGIN();
              pg8::Gemm g{XB, (const bf16_t*)(ws + WS_WEV), MTOK, EVN, DM}; pg8::StaticOrder S; S.init(MTOK, EVN, G, bx);
              pg8::EpiBf16<1> E{H, EVP, 2048, nullptr}; pg8::gemm_phase(lds, tid, g, S, E);
              { const int ntile = (MTOK / 256) * (EVN / 256); const int first_idle = ntile % G;
                const int nidle = (first_idle == 0) ? G : G - first_idle; const int me = (first_idle == 0) ? bx : bx - first_idle;
                if (me >= 0) { __syncthreads(); convert_loop<false>(Pz, lds, 0, me * 8 + wid, nidle * 8, wid, lane, IT_P0_END + li * IT_SLOT, IT_P0_END + (li + 1) * IT_SLOT); } } }
            GRID_SYNC();
            DUPLOOP(2) if (PH_ON(2)) {
                PHASE_BEGIN();
                bf16_t* MIX = XB; const float* cw = Pz.in[5] + (size_t)li * 3 * 1024;
                { f32x4* sz = (f32x4*)(ws + WS_STATS); for (int i = bx * 512 + tid; i < MTOK * 2 / 4; i += G * 512) sz[i] = (f32x4){0.f, 0.f, 0.f, 0.f}; }
                const int cskip = (G > 128) ? 128 : 0;
#pragma unroll 1
                for (int it = (bx - cskip) * 512 + tid; it < MTOK * 128 && bx >= cskip; it += (G - cskip) * 512) {
                    const int row = it >> 7, cv = (it & 127) * 8, t = row & (SEQ - 1);
                    const bf16_t* hp = H + (size_t)row * EVP;
                    float pr[3][8];
#pragma unroll
                    for (int k = 0; k < 3; ++k) {
                        const int kc = t >= k ? k : 0; float a[8];
                        unpack8(*(const bf16x8*)(hp - (size_t)kc * EVP + C_P + cv), a);
#pragma unroll
                        for (int e = 0; e < 8; ++e) pr[k][e] = t >= k ? a[e] : 0.f; }
                    float gz[8]; unpack8(*(const bf16x8*)(hp + C_GZ + cv), gz);
                    float y[8];
#pragma unroll
                    for (int e = 0; e < 8; ++e) { const float cvv = cw[cv + e] * pr[2][e] + cw[1024 + cv + e] * pr[1][e] + cw[2048 + cv + e] * pr[0][e]; y[e] = gz[e] * cvv; }
                    *(bf16x8*)(MIX + (size_t)row * DM + cv) = pack8((f32x4){y[0], y[1], y[2], y[3]}, (f32x4){y[4], y[5], y[6], y[7]});
                }
            }
            DUPLOOP(4) if (PH_ON(4)) { PHASE_BEGIN();
#pragma unroll 1
              for (int c = bx; c < 128; c += G) { const int mt = c & 7, g = (c >> 3) & 1, b = (c >> 4) & 3, kv = c >> 6; compress_unit(Pz, lds, tid, li, kv, b, g, mt); } }
            DUPLOOP(3) if (PH_ON(3)) { PHASE_BEGIN();
#pragma unroll 1
              for (int u = bx; u < 512; u += G) { const int bg = u >> 6, qt = 63 - (u & 63); attn_unit<2>(Pz, lds, tid, bg >> 1, bg & 1, qt); }
              __syncthreads(); }
            GRID_SYNC();
            DUPLOOP(5) if (PH_ON(5)) { PHASE_BEGIN();
#pragma unroll 1
              for (int pp = bx; pp < 512; pp += G) { const int pr = pp & 255, bg = pr >> 5, x = pr & 31; const int qt = (pp < 256) ? 63 - x : x;
                  attn_unit<0>(Pz, lds, tid, bg >> 1, bg & 1, qt); } }
            asm volatile("s_waitcnt vmcnt(0)" ::: "memory"); __builtin_amdgcn_fence(__ATOMIC_SEQ_CST, "agent"); __syncthreads();
            DUPLOOP(6) if (PH_ON(6)) { PHASE_BEGIN();
#pragma unroll 1
              for (int pp = bx; pp < 512; pp += G) { const int pr = pp & 255, bg = pr >> 5, x = pr & 31; const int qt = (pp < 256) ? 63 - x : x;
                  attn_unit<1>(Pz, lds, tid, bg >> 1, bg & 1, qt); } }
            GRID_SYNC();
            DUPLOOP(7) if (PH_ON(7)) { PHASE_BEGIN();
              pg8::Gemm g{XB, (const bf16_t*)(ws + WS_WOUT) + (size_t)li * DM * DM, MTOK, DM, DM}; pg8::StaticOrder S; S.init(MTOK, DM, G, bx);
              pg8::EpiBf16<0> E{H, DM, 0, nullptr}; pg8::gemm_phase(lds, tid, g, S, E); }
            GRID_SYNC();
        } else {
            DUPLOOP(8) if (PH_ON(8)) { PHASE_BEGIN();
              pg8::Gemm g{XB, (const bf16_t*)(ws + WS_WOD) + (size_t)li * ODN * DM, MTOK, ODN, DM}; pg8::StaticOrder S; S.init(MTOK, ODN, G, bx);
              pg8::EpiBf16<2> E{H, ODP, 2048, (float*)(ws + WS_STATS)}; pg8::gemm_phase(lds, tid, g, S, E); }
            GRID_SYNC();
            DUPLOOP(9) if (PH_ON(9)) { PHASE_BEGIN();
#pragma unroll 1
              for (int u = bx; u < 1024; u += G) { const int g = u & 7, ch = (u >> 3) & 31, b = u >> 8; sgu_unit(Pz, lds, tid, li, b, ch, g); } }
            GRID_SYNC();
            DUPLOOP(10) if (PH_ON(10)) { PHASE_BEGIN();
              pg8::Gemm g{XB, (const bf16_t*)(ws + WS_WOUT) + (size_t)(2 + li) * DM * DM, MTOK, DM, DM}; pg8::StaticOrder S; S.init(MTOK, DM, G, bx);
              pg8::EpiBf16<0> E{H, DM, 0, nullptr}; pg8::gemm_phase(lds, tid, g, S, E); }
            GRID_SYNC();
        }
        DUPLOOP(11) if (PH_ON(11)) { PHASE_BEGIN();
          const float* xres = (layer == 0) ? Pz.in[0] : XF;
          if (layer == 3) ln_phase<true>(Pz.in[2] + (size_t)layer * DM, Pz.in[3] + (size_t)layer * DM, xres, H, XF, XB, gw, NGW, lane);
          else ln_phase<false>(Pz.in[2] + (size_t)layer * DM, Pz.in[3] + (size_t)layer * DM, xres, H, XF, XB, gw, NGW, lane);
          if (layer == 0) { __syncthreads(); convert_loop<true>(Pz, lds, 1, gw, NGW, wid, lane); } }
        if (layer < 3) GRID_SYNC();
#undef GRID_SYNC
}

__global__ void __launch_bounds__(512, 2) hybrid_fwd(Params P) {
    extern __shared__ __attribute__((aligned(16))) unsigned char lds_raw[];
    cg::grid_group grid = cg::this_grid();
    if (threadIdx.x < 4) ((volatile LAS unsigned*)((ldsp)lds_raw + LDS_ST_OFF))[threadIdx.x] = 0u;
    __syncthreads();
    const XcdBarrier xbar = xcd_barrier_post((unsigned*)(P.ws + WS_BAR), (volatile LAS unsigned*)((ldsp)lds_raw + LDS_ST_OFF));
#define GRID_SYNC() xcd_barrier(xbar)

    int layer_dup_ok = 1; (void)layer_dup_ok;
    DUPLOOP(0) if (PH_ON(0)) {
        PHASE_BEGIN();
        convert_loop<false>(Pz, lds, 0, gw, NGW, wid, lane, 0, IT_P0_END);
        { bf16x8* WF = (bf16x8*)(ws + WS_SGW);
          for (int it = bx * 512 + tid; it < 2 * 8 * 4 * 2 * 4 * 64; it += G * 512) {
              const int ln = it & 63, i = (it >> 6) & 3, st = (it >> 8) & 1, rt = (it >> 9) & 3, lg = it >> 11;
              const int t = rt * 32 + (ln & 31), s0 = st * 64 + 16 * i + 8 * (ln >> 5);
              const float* wp = Pz.in[13] + ((size_t)lg * 128 + t) * 128 + s0;
              f32x4 w0 = *(const f32x4*)wp, w1 = *(const f32x4*)(wp + 4);
#pragma unroll
              for (int e = 0; e < 4; ++e) { if (s0 + e > t) w0[e] = 0.f; if (s0 + 4 + e > t) w1[e] = 0.f; }
              WF[it] = pack8(w0, w1); } }
        const float* x = Pz.in[0];
#pragma unroll 4
        for (size_t i = (size_t)bx * 512 + tid; i < (size_t)MTOK * DM / 8; i += (size_t)G * 512) {
            const f32x4 a = *(const f32x4*)(x + i * 8), c = *(const f32x4*)(x + i * 8 + 4);
            *(bf16x8*)(XB + i * 8) = pack8(a, c); }
    }
    if (P.ws == nullptr) grid.sync();
    GRID_SYNC();

#if (DUP_MASK >> 12) & 1
#pragma unroll 1
    for (int q_ = 0; q_ < 20; ++q_) GRID_SYNC();
#endif
    layer_body<0>(lds_raw, xbar, 1); layer_body<1>(lds_raw, xbar, 1); layer_body<2>(lds_raw, xbar, 0); layer_body<3>(lds_raw, xbar, 0);
}

extern "C" void kernel_launch(void* const* d_in, const int* in_sizes, int n_in, void* d_out, int out_size, void* d_ws, size_t ws_size, hipStream_t stream) {
    static int grid = 0;
    if (grid == 0) {
        if (n_in != 16 || out_size != MTOK * DM || ws_size < WS_END) { fprintf(stderr, "kernel_launch: unexpected shapes (n_in %d out %d ws %zu)\n", n_in, out_size, ws_size); grid = -1; return; }
        int dev = 0, cus = 0, per_cu = 0;
        (void)hipGetDevice(&dev);
        (void)hipDeviceGetAttribute(&cus, hipDeviceAttributeMultiprocessorCount, dev);
        (void)hipFuncSetAttribute((const void*)hybrid_fwd, hipFuncAttributeMaxDynamicSharedMemorySize, LDS_BYTES);
        (void)hipOccupancyMaxActiveBlocksPerMultiprocessor(&per_cu, (const void*)hybrid_fwd, 512, LDS_BYTES);
        if (per_cu < 1) { fprintf(stderr, "kernel_launch: occupancy query says %d blocks/CU\n", per_cu); per_cu = 1; }
        (void)hipGetLastError();
        grid = cus > 0 ? cus : 256;
    }
    if (grid < 0) return;
    if (hipMemsetAsync(d_ws, 0, CTL_ZERO_BYTES, stream) != hipSuccess) { fprintf(stderr, "kernel_launch: memset of control words failed\n"); return; }
    Params p{};
    for (int i = 0; i < 16; ++i) p.in[i] = (const float*)d_in[i];
    p.out = (float*)d_out; p.ws = (unsigned char*)d_ws;
    void* args[] = {&p};
    hipError_t e = hipLaunchCooperativeKernel((const void*)hybrid_fwd, dim3(grid), dim3(512), args, LDS_BYTES, stream);
    if (e != hipSuccess) fprintf(stderr, "cooperative launch failed: %s (grid %d)\n", hipGetErrorString(e), grid);
}
```
